# Optimizing an MI355X kernel written in HIP

```python
import jax
import jax.numpy as jnp
from jax import lax
import numpy as np

D_MODEL = 1024
BATCH = 8
SEQ = 4096
DEPTH = 2

CTX_LEN = 256
GRID_W = 64
MIX_WIDTH = D_MODEL
A_WIDTH = MIX_WIDTH // 2
A_GROUPS = 4
A_GROUP_CH = A_WIDTH // A_GROUPS
A_CHUNK = 128
NA_HEADS = 8
NA_HEAD_DIM = (MIX_WIDTH - A_WIDTH) // NA_HEADS
NA_WIDTH = NA_HEADS * NA_HEAD_DIM
NA_WIN_ROWS = 8
NA_WIN_COLS = 16
O_NA_Q = 2 * A_WIDTH
O_NA_K = O_NA_Q + NA_WIDTH
O_NA_V = O_NA_K + NA_WIDTH
AB_IN_WIDTH = O_NA_V + NA_WIDTH
FN_WIDTH = MIX_WIDTH // 2
FN_GROUPS = 4
FN_GROUP_CH = FN_WIDTH // FN_GROUPS
GLA_HEADS = 4
GLA_VAL_WIDTH = MIX_WIDTH - FN_WIDTH
GLA_KEY_WIDTH = GLA_VAL_WIDTH // 2
GLA_DK = GLA_KEY_WIDTH // GLA_HEADS
GLA_DV = GLA_VAL_WIDTH // GLA_HEADS
GLA_LOW_RANK = 16
GLA_GATE_TEMP = 16.0
GLA_CHUNK = 64
O_Q = FN_WIDTH
O_K = O_Q + GLA_KEY_WIDTH
O_V = O_K + GLA_KEY_WIDTH
O_G = O_V + GLA_VAL_WIDTH
O_A = O_G + GLA_VAL_WIDTH
CD_IN_WIDTH = O_A + 2 * GLA_LOW_RANK
FFN_HIDDEN = -(-8 * D_MODEL // (3 * 256)) * 256
ROPE_BASE = 10000.0
RMS_EPS = 1e-6
NEG_INF = -1e30
N_EVEN = (DEPTH + 1) // 2
N_ODD = DEPTH // 2

kernel_name = "hybrid_dit_gmlp_natten_fnet_gla"


def rmsnorm(x, w):
    xf = x.astype(jnp.float32)
    y = xf * lax.rsqrt(jnp.mean(xf * xf, axis=-1, keepdims=True) + RMS_EPS)
    return (y * w.astype(jnp.float32)).astype(x.dtype)


def modulate(h, shift, scale):
    return h * (1.0 + scale) + shift


def swiglu(h, w_gate, w_up, w_down):
    return (jax.nn.silu(h @ w_gate) * (h @ w_up)) @ w_down


def _rope_1d(xh, pos):
    half = xh.shape[-1] // 2
    inv_freq = ROPE_BASE ** (-jnp.arange(half, dtype=jnp.float32) / half)
    ang = pos.astype(jnp.float32)[:, None] * inv_freq[None, :]
    cos = jnp.cos(ang)[None, :, None, :].astype(xh.dtype)
    sin = jnp.sin(ang)[None, :, None, :].astype(xh.dtype)
    x1, x2 = xh[..., :half], xh[..., half:]
    return jnp.concatenate([x1 * cos - x2 * sin, x2 * cos + x1 * sin], axis=-1)


def axial_rope(x):
    t = jnp.arange(x.shape[1])
    d2 = x.shape[-1] // 2
    return jnp.concatenate([_rope_1d(x[..., :d2], t // GRID_W), _rope_1d(x[..., d2:], t % GRID_W)], axis=-1)


def chunk_token_mlp(uv, norm_w, sgu_w, sgu_b):
    B, T, _ = uv.shape
    uv = jax.nn.gelu(uv)
    u, v = uv[..., :A_WIDTH], uv[..., A_WIDTH:]
    v = rmsnorm(v, norm_w)
    vg = v.reshape(B, T // A_CHUNK, A_CHUNK, A_GROUPS, A_GROUP_CH)
    gate = jnp.einsum('gpq,bnqgc->bnpgc', sgu_w, vg) + sgu_b.T[None, None, :, :, None]
    return u * gate.reshape(B, T, A_WIDTH)


def _na_heads(t):
    return t.reshape(t.shape[0], t.shape[1], NA_HEADS, NA_HEAD_DIM)


def neighbourhood_attention(q, k, v, k_ctx, v_ctx, rel_bias):
    B, T, H, dh = q.shape
    rows = T // GRID_W
    wr = min(NA_WIN_ROWS, rows)
    scale = dh ** -0.5
    qg = q.reshape(B, rows, GRID_W, H, dh)
    kg = k.reshape(B, rows, GRID_W, H, dh)
    vg = v.reshape(B, rows, GRID_W, H, dh)
    col = jnp.arange(GRID_W)
    col_start = jnp.clip(col - NA_WIN_COLS // 2, 0, GRID_W - NA_WIN_COLS)
    col_mask = (col[None, :] >= col_start[:, None]) & (col[None, :] < col_start[:, None] + NA_WIN_COLS)
    col_idx = jnp.clip(col[None, :] - col[:, None] + NA_WIN_COLS - 1, 0, 2 * NA_WIN_COLS - 2)

    def row_block(r):
        row_start = jnp.clip(r - wr // 2, 0, rows - wr)
        qr = lax.dynamic_index_in_dim(qg, r, axis=1, keepdims=False)
        kb = lax.dynamic_slice_in_dim(kg, row_start, wr, axis=1)
        vb = lax.dynamic_slice_in_dim(vg, row_start, wr, axis=1)
        row_idx = row_start + jnp.arange(wr) - r + NA_WIN_ROWS - 1
        bias = jnp.transpose(rel_bias[:, row_idx][:, :, col_idx], (0, 2, 1, 3))
        s_nb = jnp.einsum('bqhd,bwkhd->bhqwk', qr, kb).astype(jnp.float32) * scale + bias[None].astype(jnp.float32)
        s_nb = jnp.where(col_mask[:, None, :], s_nb, NEG_INF).reshape(B, H, GRID_W, wr * GRID_W)
        s_cx = jnp.einsum('bqhd,bchd->bhqc', qr, k_ctx).astype(jnp.float32) * scale
        p = jax.nn.softmax(jnp.concatenate([s_nb, s_cx], axis=-1), axis=-1).astype(v.dtype)
        p_nb = p[..., :wr * GRID_W].reshape(B, H, GRID_W, wr, GRID_W)
        p_cx = p[..., wr * GRID_W:]
        return jnp.einsum('bhqwk,bwkhd->bqhd', p_nb, vb) + jnp.einsum('bhqc,bchd->bqhd', p_cx, v_ctx)

    out = lax.map(row_block, jnp.arange(rows))
    return jnp.moveaxis(out, 0, 1).reshape(B, T, H * dh)


def context_attention(q, k, v):
    B, T, H, dh = q.shape
    s = jnp.einsum('bqhd,bkhd->bhqk', q, k).astype(jnp.float32) * dh ** -0.5
    p = jax.nn.softmax(s, axis=-1).astype(v.dtype)
    return jnp.einsum('bhqk,bkhd->bqhd', p, v).reshape(B, T, H * dh)


def ab_mixer(h, hc, w_in, w_out, sgu_norm_w, sgu_w, sgu_b, rel_bias, with_ctx_out):
    p = h @ w_in
    a_out = chunk_token_mlp(p[..., :O_NA_Q], sgu_norm_w, sgu_w, sgu_b)
    q_l = _na_heads(p[..., O_NA_Q:O_NA_K])
    k_l = _na_heads(p[..., O_NA_K:O_NA_V])
    v_l = _na_heads(p[..., O_NA_V:])
    if with_ctx_out:
        pc = hc @ w_in
        kv_c = pc[..., O_NA_K:]
    else:
        pc = None
        kv_c = hc @ w_in[:, O_NA_K:]
    k_c = _na_heads(kv_c[..., :NA_WIDTH])
    v_c = _na_heads(kv_c[..., NA_WIDTH:])
    b_out = neighbourhood_attention(q_l, k_l, v_l, k_c, v_c, rel_bias)
    y = jnp.concatenate([a_out, b_out], axis=-1) @ w_out
    if not with_ctx_out:
        return y, None
    a_c = chunk_token_mlp(pc[..., :O_NA_Q], sgu_norm_w, sgu_w, sgu_b)
    b_c = context_attention(_na_heads(pc[..., O_NA_Q:O_NA_K]), k_c, v_c)
    y_c = jnp.concatenate([a_c, b_c], axis=-1) @ w_out
    return y, y_c


def fourier_mix(f):
    B, T, _ = f.shape
    fg = f.reshape(B, T, FN_GROUPS, FN_GROUP_CH).astype(jnp.float32)
    out = jnp.fft.fft2(fg, axes=(1, 3), norm='ortho').real
    return out.reshape(B, T, FN_WIDTH).astype(f.dtype)


def _to_heads(t, n_heads):
    B, T, _ = t.shape
    return jnp.transpose(t.reshape(B, T, n_heads, -1), (0, 2, 1, 3))


def log_decay(a_lr, w, b):
    return jax.nn.log_sigmoid((a_lr @ w + b).astype(jnp.float32)) / GLA_GATE_TEMP


def _gla_chunk_terms(k, v, log_a):
    B, H, T, dk = k.shape
    n = T // GLA_CHUNK
    kc = k.reshape(B, H, n, GLA_CHUNK, dk)
    vc = v.reshape(B, H, n, GLA_CHUNK, -1)
    b = jnp.cumsum(log_a.reshape(B, H, n, GLA_CHUNK, dk), axis=3)
    b_last = b[:, :, :, -1:, :]
    kv = jnp.einsum('bhnld,bhnle->bhnde', kc * jnp.exp(b_last - b), vc)
    return kc, vc, b, kv, jnp.exp(b_last[:, :, :, 0, :])


def _gla_scan(kv, decay, s0):
    def step(s, inp):
        d, kv_n = inp
        return d[..., None] * s + kv_n, s
    s_fin, s_prev = lax.scan(step, s0, (jnp.moveaxis(decay, 2, 0), jnp.moveaxis(kv, 2, 0)))
    return jnp.moveaxis(s_prev, 0, 2), s_fin


def gla_final_state(k, v, log_a, s0):
    _, _, _, kv, decay = _gla_chunk_terms(k, v, log_a)
    _, s_fin = _gla_scan(kv, decay, s0)
    return s_fin


def gla_chunked(q, k, v, log_a, s0):
    B, H, T, dk = q.shape
    kc, vc, b, kv, decay = _gla_chunk_terms(k, v, log_a)
    s_prev, s_fin = _gla_scan(kv, decay, s0)
    qe = q.reshape(B, H, -1, GLA_CHUNK, dk) * jnp.exp(b)
    lower = jnp.tril(jnp.ones((GLA_CHUNK, GLA_CHUNK), jnp.float32))
    att = jnp.einsum('bhnld,bhnmd->bhnlm', qe, kc * jnp.exp(-b)) * lower
    o = jnp.einsum('bhnlm,bhnme->bhnle', att, vc) + jnp.einsum('bhnld,bhnde->bhnle', qe, s_prev)
    return o.reshape(B, H, T, -1), s_fin


def gla_output(o, g, head_norm_w):
    B, H, T, dv = o.shape
    o = rmsnorm(jnp.transpose(o, (0, 2, 1, 3)), head_norm_w)
    return (o * jax.nn.silu(g.reshape(B, T, H, dv).astype(jnp.float32))).reshape(B, T, H * dv).astype(g.dtype)


def _split_cd(p):
    return p[..., :O_Q], p[..., O_Q:O_K], p[..., O_K:O_V], p[..., O_V:O_G], p[..., O_G:O_A], p[..., O_A:]


def cd_mixer(h, hc, w_in, w_out, dec_w_f, dec_b_f, dec_w_b, dec_b_b, head_norm_w, with_ctx_out):
    B, T, _ = h.shape
    f32 = jnp.float32
    flip = lambda t: jnp.flip(t, axis=2)
    f_l, q_l, k_l, v_l, g_l, a_l = _split_cd(h @ w_in)
    q_l = axial_rope(q_l.reshape(B, T, GLA_HEADS, GLA_DK)) * GLA_DK ** -0.5
    k_l = axial_rope(k_l.reshape(B, T, GLA_HEADS, GLA_DK))
    ql = jnp.transpose(q_l, (0, 2, 1, 3)).astype(f32)
    kl = jnp.transpose(k_l, (0, 2, 1, 3)).astype(f32)
    vl = _to_heads(v_l, GLA_HEADS).astype(f32)
    la_lf = _to_heads(log_decay(a_l[..., :GLA_LOW_RANK], dec_w_f, dec_b_f), GLA_HEADS)
    la_lb = _to_heads(log_decay(a_l[..., GLA_LOW_RANK:], dec_w_b, dec_b_b), GLA_HEADS)
    if with_ctx_out:
        f_c, q_c, k_c, v_c, g_c, a_c = _split_cd(hc @ w_in)
    else:
        pc = hc @ jnp.concatenate([w_in[:, O_K:O_G], w_in[:, O_A:]], axis=1)
        k_c = pc[..., :GLA_KEY_WIDTH]
        v_c = pc[..., GLA_KEY_WIDTH:GLA_KEY_WIDTH + GLA_VAL_WIDTH]
        a_c = pc[..., GLA_KEY_WIDTH + GLA_VAL_WIDTH:]
    kc = _to_heads(k_c, GLA_HEADS).astype(f32)
    vc = _to_heads(v_c, GLA_HEADS).astype(f32)
    la_cf = _to_heads(log_decay(a_c[..., :GLA_LOW_RANK], dec_w_f, dec_b_f), GLA_HEADS)
    la_cb = _to_heads(log_decay(a_c[..., GLA_LOW_RANK:], dec_w_b, dec_b_b), GLA_HEADS)
    s0 = jnp.zeros((hc.shape[0], GLA_HEADS, GLA_DK, GLA_DV), f32)
    if with_ctx_out:
        qc = (_to_heads(q_c, GLA_HEADS) * GLA_DK ** -0.5).astype(f32)
        o_cf, s_f = gla_chunked(qc, kc, vc, la_cf, s0)
        o_cb, s_b = gla_chunked(flip(qc), flip(kc), flip(vc), flip(la_cb), s0)
        o_c = o_cf + flip(o_cb)
    else:
        s_f = gla_final_state(kc, vc, la_cf, s0)
        s_b = gla_final_state(flip(kc), flip(vc), flip(la_cb), s0)
    o_lf, _ = gla_chunked(ql, kl, vl, la_lf, s_f)
    o_lb, _ = gla_chunked(flip(ql), flip(kl), flip(vl), flip(la_lb), s_b)
    o_l = o_lf + flip(o_lb)
    y = jnp.concatenate([fourier_mix(f_l), gla_output(o_l, g_l, head_norm_w)], axis=-1) @ w_out
    if not with_ctx_out:
        return y, None
    y_c = jnp.concatenate([fourier_mix(f_c), gla_output(o_c, g_c, head_norm_w)], axis=-1) @ w_out
    return y, y_c


def setup_inputs(seed: int = 0) -> dict:
    key = jax.random.key(seed)
    ks = jax.random.split(key, 26)
    D = D_MODEL

    def nrm(k, shape, s):
        return jax.random.normal(k, shape, jnp.float32) * s

    return {
        'x': nrm(ks[0], (BATCH, SEQ, D), 1.0),
        'c': nrm(ks[1], (BATCH, D), 1.0),
        'ctx': nrm(ks[2], (BATCH, CTX_LEN, D), 1.0),
        'c_ctx': nrm(ks[3], (D,), 1.0),
        'ada_w': nrm(ks[4], (DEPTH, D, 6 * D), 0.5 * D ** -0.5),
        'ada_b': nrm(ks[5], (DEPTH, 6 * D), 0.02),
        'norm_mix_w': 1.0 + nrm(ks[6], (DEPTH, D), 0.05),
        'norm_ffn_w': 1.0 + nrm(ks[7], (DEPTH, D), 0.05),
        'ffn_w_gate': nrm(ks[8], (DEPTH, D, FFN_HIDDEN), D ** -0.5),
        'ffn_w_up': nrm(ks[9], (DEPTH, D, FFN_HIDDEN), D ** -0.5),
        'ffn_w_down': nrm(ks[10], (DEPTH, FFN_HIDDEN, D), FFN_HIDDEN ** -0.5),
        'ab_w_in': nrm(ks[11], (N_EVEN, D, AB_IN_WIDTH), D ** -0.5),
        'ab_w_out': nrm(ks[12], (N_EVEN, MIX_WIDTH, D), MIX_WIDTH ** -0.5),
        'ab_sgu_norm_w': 1.0 + nrm(ks[13], (N_EVEN, A_WIDTH), 0.05),
        'ab_sgu_w': nrm(ks[14], (N_EVEN, A_GROUPS, A_CHUNK, A_CHUNK), A_CHUNK ** -0.5),
        'ab_sgu_b': 1.0 + nrm(ks[15], (N_EVEN, A_GROUPS, A_CHUNK), 0.05),
        'ab_rel_bias': nrm(ks[16], (N_EVEN, NA_HEADS, 2 * NA_WIN_ROWS - 1, 2 * NA_WIN_COLS - 1), 0.5),
        'cd_w_in': nrm(ks[17], (N_ODD, D, CD_IN_WIDTH), D ** -0.5),
        'cd_w_out': nrm(ks[18], (N_ODD, MIX_WIDTH, D), MIX_WIDTH ** -0.5),
        'cd_decay_w_fwd': nrm(ks[19], (N_ODD, GLA_LOW_RANK, GLA_KEY_WIDTH), GLA_LOW_RANK ** -0.5),
        'cd_decay_b_fwd': nrm(ks[20], (N_ODD, GLA_KEY_WIDTH), 0.1),
        'cd_decay_w_bwd': nrm(ks[21], (N_ODD, GLA_LOW_RANK, GLA_KEY_WIDTH), GLA_LOW_RANK ** -0.5),
        'cd_decay_b_bwd': nrm(ks[22], (N_ODD, GLA_KEY_WIDTH), 0.1),
        'cd_head_norm_w': 1.0 + nrm(ks[23], (N_ODD, GLA_DV), 0.05),
        'final_norm_w': 1.0 + nrm(ks[24], (D,), 0.05),
    }


def reference(x, c, ctx, c_ctx, ada_w, ada_b, norm_mix_w, norm_ffn_w, ffn_w_gate, ffn_w_up, ffn_w_down,
              ab_w_in, ab_w_out, ab_sgu_norm_w, ab_sgu_w, ab_sgu_b, ab_rel_bias,
              cd_w_in, cd_w_out, cd_decay_w_fwd, cd_decay_b_fwd, cd_decay_w_bwd, cd_decay_b_bwd, cd_head_norm_w,
              final_norm_w):
    silu_c = jax.nn.silu(c)
    silu_cc = jax.nn.silu(c_ctx)
    for i in range(DEPTH):
        last = i == DEPTH - 1
        j = i // 2
        mod = (silu_c @ ada_w[i] + ada_b[i])[:, None, :]
        mod_c = (silu_cc @ ada_w[i] + ada_b[i])[None, None, :]
        sh_m, sc_m, g_m, sh_f, sc_f, g_f = jnp.split(mod, 6, axis=-1)
        shc_m, scc_m, gc_m, shc_f, scc_f, gc_f = jnp.split(mod_c, 6, axis=-1)
        h = modulate(rmsnorm(x, norm_mix_w[i]), sh_m, sc_m)
        hc = modulate(rmsnorm(ctx, norm_mix_w[i]), shc_m, scc_m)
        if i % 2 == 0:
            y, y_c = ab_mixer(h, hc, ab_w_in[j], ab_w_out[j], ab_sgu_norm_w[j], ab_sgu_w[j], ab_sgu_b[j],
                              ab_rel_bias[j], not last)
        else:
            y, y_c = cd_mixer(h, hc, cd_w_in[j], cd_w_out[j], cd_decay_w_fwd[j], cd_decay_b_fwd[j],
                              cd_decay_w_bwd[j], cd_decay_b_bwd[j], cd_head_norm_w[j], not last)
        x = x + g_m * y
        x = x + g_f * swiglu(modulate(rmsnorm(x, norm_ffn_w[i]), sh_f, sc_f), ffn_w_gate[i], ffn_w_up[i], ffn_w_down[i])
        if not last:
            ctx = ctx + gc_m * y_c
            ctx = ctx + gc_f * swiglu(modulate(rmsnorm(ctx, norm_ffn_w[i]), shc_f, scc_f),
                                      ffn_w_gate[i], ffn_w_up[i], ffn_w_down[i])
    return rmsnorm(x, final_norm_w)
```

```cpp
#include <hip/hip_runtime.h>
#include <hip/hip_cooperative_groups.h>
#include <cstdio>
namespace cg = cooperative_groups;

typedef unsigned short bf16_t;
typedef short bf16x8 __attribute__((ext_vector_type(8)));
typedef float f32x4 __attribute__((ext_vector_type(4)));

#define NT 256
constexpr int D = 1024, SEQ = 4096, NB = 8, CTXL = 256;
constexpr int ROWS_L = NB * SEQ;
constexpr int ROWS_C = NB * CTXL;
constexpr int ROWS = ROWS_L + ROWS_C;
constexpr int FFN = 2816;
constexpr int NIN0 = 2560, NIN1 = 2080, NIN1P = 2176;
constexpr int MODN = 6144;
constexpr int LDK = 72;

constexpr size_t MiB = (size_t)1 << 20;
constexpr size_t OFF_WIN0 = 0, OFF_WOUT0 = 5 * MiB, OFF_WGU0 = 7 * MiB, OFF_WD0 = 18 * MiB;
constexpr size_t OFF_WIN1 = 24 * MiB, OFF_WOUT1 = 29 * MiB, OFF_WGU1 = 31 * MiB, OFF_WD1 = 42 * MiB;
constexpr size_t OFF_MOD = 48 * MiB;
constexpr size_t OFF_TAB = 48 * MiB + 512 * 1024;
constexpr size_t OFF_BAR = 48 * MiB + 768 * 1024;
constexpr size_t OFF_XRES = 49 * MiB;
constexpr size_t OFF_HM = 185 * MiB;
constexpr size_t OFF_BIG = 253 * MiB;
constexpr size_t OFF_APR = OFF_BIG + 145 * MiB;
constexpr size_t OFF_API = OFF_BIG + 161 * MiB;
constexpr size_t OFF_EXTRA = 440 * MiB;
constexpr size_t WS_NEED = 508 * MiB;

struct Params {
  const float *x, *c, *ctx, *c_ctx, *ada_w, *ada_b, *norm_mix_w, *norm_ffn_w, *ffn_w_gate, *ffn_w_up, *ffn_w_down;
  const float *ab_w_in, *ab_w_out, *ab_sgu_norm_w, *ab_sgu_w, *ab_sgu_b, *ab_rel_bias;
  const float *cd_w_in, *cd_w_out, *cd_dw_f, *cd_db_f, *cd_dw_b, *cd_db_b, *cd_head_norm_w, *final_norm_w;
  float* out;
  char* ws;
};

__device__ __forceinline__ bf16_t f2bf(float f) {
  unsigned u = __float_as_uint(f);
  u += 0x7fffu + ((u >> 16) & 1u);
  return (bf16_t)(u >> 16);
}
__device__ __forceinline__ float bf2f(bf16_t h) { return __uint_as_float(((unsigned)h) << 16); }
__device__ __forceinline__ unsigned pack2(float a, float b) { return (unsigned)f2bf(a) | ((unsigned)f2bf(b) << 16); }
__device__ __forceinline__ float lo_bf(unsigned u) { return __uint_as_float(u << 16); }
__device__ __forceinline__ float hi_bf(unsigned u) { return __uint_as_float(u & 0xffff0000u); }
__device__ __forceinline__ float sigmoidf_(float x) { return 1.f / (1.f + __expf(-x)); }
__device__ __forceinline__ float siluf_(float x) { return x * sigmoidf_(x); }
__device__ __forceinline__ float geluf_(float x) {
  float u = 0.7978845608028654f * (x + 0.044715f * x * x * x);
  return x * sigmoidf_(2.f * u);
}
__device__ __forceinline__ float wave_sum(float v) {
#pragma unroll
  for (int o = 32; o > 0; o >>= 1) v += __shfl_xor(v, o);
  return v;
}
__device__ __forceinline__ float cos_rev(float r) { return __builtin_amdgcn_cosf(r); }
__device__ __forceinline__ float sin_rev(float r) { return __builtin_amdgcn_sinf(r); }

__device__ __forceinline__ void wt_tile(const float* __restrict__ src, const float* __restrict__ src2, int N, int ldsrc, bf16_t* __restrict__ dst,
                        int lddst, int kt, int ntile, int mode, float* tile) {
  const int tid = threadIdx.x;
#pragma unroll
  for (int i = 0; i < 4; ++i) {
    const int kk = (tid >> 4) + i * 16, j4 = (tid & 15) * 4;
    float4 v = make_float4(0.f, 0.f, 0.f, 0.f);
    if (mode == 0) {
      const int col = ntile * 64 + j4;
      if (col < N) v = *(const float4*)(src + (size_t)(kt * 64 + kk) * ldsrc + col);
    } else {
      const int col = ntile * 32 + (j4 & 31);
      const float* sp = (j4 < 32) ? src : src2;
      v = *(const float4*)(sp + (size_t)(kt * 64 + kk) * ldsrc + col);
    }
    tile[(j4 + 0) * 65 + kk] = v.x; tile[(j4 + 1) * 65 + kk] = v.y; tile[(j4 + 2) * 65 + kk] = v.z; tile[(j4 + 3) * 65 + kk] = v.w;
  }
  __syncthreads();
#pragma unroll
  for (int i = 0; i < 2; ++i) {
    const int e = tid + i * 256, j = e >> 3, k8 = (e & 7) * 8;
    const float* tp = tile + j * 65 + k8;
    uint4 pk; pk.x = pack2(tp[0], tp[1]); pk.y = pack2(tp[2], tp[3]); pk.z = pack2(tp[4], tp[5]); pk.w = pack2(tp[6], tp[7]);
    *(uint4*)(dst + (size_t)(ntile * 64 + j) * lddst + kt * 64 + k8) = pk;
  }
  __syncthreads();
}

__device__ __forceinline__ void mod_item(const Params& p, int item, float* sm) {
  const int l = item / 96, cgp = item % 96;
  const int tid = threadIdx.x, nn = tid & 63, ks = tid >> 6;
  float* sil = sm;
  float* red = sm + 4 * 9 * 256;
  for (int e = tid; e < 9 * 1024; e += NT) {
    int v = e >> 10, k = e & 1023;
    float cv = (v < 8) ? p.c[v * 1024 + k] : p.c_ctx[k];
    sil[((k >> 8) * 9 + v) * 256 + (k & 255)] = siluf_(cv);
  }
  __syncthreads();
  float acc[9];
#pragma unroll
  for (int v = 0; v < 9; ++v) acc[v] = 0.f;
  const float* w = p.ada_w + (size_t)l * 1024 * MODN + cgp * 64 + nn;
#pragma unroll 16
  for (int k = 0; k < 256; ++k) {
    float wv = w[(size_t)(ks * 256 + k) * MODN];
#pragma unroll
    for (int v = 0; v < 9; ++v) acc[v] += sil[(ks * 9 + v) * 256 + k] * wv;
  }
#pragma unroll
  for (int v = 0; v < 9; ++v) red[(ks * 9 + v) * 64 + nn] = acc[v];
  __syncthreads();
  float* mod = (float*)(p.ws + OFF_MOD);
  for (int e = tid; e < 9 * 64; e += NT) {
    int v = e >> 6, n = e & 63;
    float s = red[(0 * 9 + v) * 64 + n] + red[(1 * 9 + v) * 64 + n] + red[(2 * 9 + v) * 64 + n] + red[(3 * 9 + v) * 64 + n];
    mod[((size_t)l * 9 + v) * MODN + cgp * 64 + n] = s + p.ada_b[l * MODN + cgp * 64 + n];
  }
  __syncthreads();
}

__device__ __forceinline__ void phase_prep(const Params& p, char* smem) {
  float* sm = (float*)smem;
  bf16_t* W = (bf16_t*)p.ws;
  const int n_in0 = 16 * 40, n_out = 16 * 16, n_gu = 16 * 88, n_d = 44 * 16, n_in1 = 16 * 34;
  const int c0 = n_in0, c1 = c0 + n_out, c2 = c1 + n_gu, c3 = c2 + n_d, c4 = c3 + n_in1, c5 = c4 + n_out, c6 = c5 + n_gu, c7 = c6 + n_d;
  const int total = c7 + 192 + 1;
  for (int it = blockIdx.x; it < total; it += gridDim.x) {
    if (it < c0) { int t = it; wt_tile(p.ab_w_in, nullptr, NIN0, NIN0, (bf16_t*)(p.ws + OFF_WIN0), 1024, t / 40, t % 40, 0, sm); }
    else if (it < c1) { int t = it - c0; wt_tile(p.ab_w_out, nullptr, 1024, 1024, (bf16_t*)(p.ws + OFF_WOUT0), 1024, t / 16, t % 16, 0, sm); }
    else if (it < c2) { int t = it - c1; wt_tile(p.ffn_w_gate, p.ffn_w_up, FFN, FFN, (bf16_t*)(p.ws + OFF_WGU0), 1024, t / 88, t % 88, 1, sm); }
    else if (it < c3) { int t = it - c2; wt_tile(p.ffn_w_down, nullptr, 1024, 1024, (bf16_t*)(p.ws + OFF_WD0), FFN, t / 16, t % 16, 0, sm); }
    else if (it < c4) { int t = it - c3; wt_tile(p.cd_w_in, nullptr, NIN1, NIN1, (bf16_t*)(p.ws + OFF_WIN1), 1024, t / 34, t % 34, 0, sm); }
    else if (it < c5) { int t = it - c4; wt_tile(p.cd_w_out, nullptr, 1024, 1024, (bf16_t*)(p.ws + OFF_WOUT1), 1024, t / 16, t % 16, 0, sm); }
    else if (it < c6) { int t = it - c5; wt_tile(p.ffn_w_gate + (size_t)1024 * FFN, p.ffn_w_up + (size_t)1024 * FFN, FFN, FFN, (bf16_t*)(p.ws + OFF_WGU1), 1024, t / 88, t % 88, 1, sm); }
    else if (it < c7) { int t = it - c6; wt_tile(p.ffn_w_down + (size_t)FFN * 1024, nullptr, 1024, 1024, (bf16_t*)(p.ws + OFF_WD1), FFN, t / 16, t % 16, 0, sm); }
    else if (it < c7 + 192) { mod_item(p, it - c7, sm); }
    else {
      float* tab = (float*)(p.ws + OFF_TAB);
      for (int e = threadIdx.x; e < 128; e += NT) { tab[e] = cos_rev(e / 128.f); tab[128 + e] = sin_rev(e / 128.f); }
      for (int e = threadIdx.x; e < 64; e += NT) { tab[256 + e] = cos_rev(e / 64.f); tab[320 + e] = sin_rev(e / 64.f); }
      for (int e = threadIdx.x; e < 4096; e += NT) { tab[384 + e] = cos_rev(e / 4096.f); tab[4480 + e] = sin_rev(e / 4096.f); }
      for (int e = threadIdx.x; e < 1024; e += NT) {
        int pos = e >> 4, i = e & 15;
        float inv = __expf(-(float)i / 16.f * 9.210340371976184f);
        float ang = (float)pos * inv;
        float rev = ang * 0.15915494309189535f;
        rev = rev - floorf(rev);
        tab[8576 + e] = cos_rev(rev); tab[9600 + e] = sin_rev(rev);
      }
      bf16_t* t1 = (bf16_t*)(p.ws + OFF_TAB + 65536);
      for (int e = threadIdx.x; e < 32768; e += NT) {
        const int n = e >> 7, cidx = e & 127;
        const float rev = (float)((cidx * (n & 127)) & 127) / 128.f;
        t1[e] = f2bf(n < 128 ? cos_rev(rev) : -sin_rev(rev));
      }
      bf16_t* c64 = t1 + 32768;
      for (int e = threadIdx.x; e < 4096; e += NT) {
        const float rev = (float)(((e >> 6) * (e & 63)) & 63) / 64.f;
        const float cv = cos_rev(rev), sv = sin_rev(rev);
        c64[e] = f2bf(cv); c64[4096 + e] = f2bf(sv); c64[8192 + e] = f2bf(-sv);
      }
    }
  }
}

__device__ __forceinline__ void phase_norm(const float* __restrict__ src_lat, const float* __restrict__ src_ctx, const float* __restrict__ w,
                           const float* __restrict__ modl  , int sh_off, int sc_off, bf16_t* __restrict__ dst, int nrows) {
  const int lane = threadIdx.x & 63, wid = threadIdx.x >> 6;
  for (int r = blockIdx.x * 4 + wid; r < nrows; r += gridDim.x * 4) {
    const float* s = (r < ROWS_L) ? src_lat + (size_t)r * 1024 : src_ctx + (size_t)(r - ROWS_L) * 1024;
    const int vec = (r < ROWS_L) ? (r >> 12) : 8;
    const float* mv = modl + (size_t)vec * MODN;
    float4 v[4];
    float ss = 0.f;
#pragma unroll
    for (int i = 0; i < 4; ++i) {
      v[i] = *(const float4*)(s + i * 256 + lane * 4);
      ss += v[i].x * v[i].x + v[i].y * v[i].y + v[i].z * v[i].z + v[i].w * v[i].w;
    }
    ss = wave_sum(ss);
    const float rstd = rsqrtf(ss * (1.f / 1024.f) + 1e-6f);
#pragma unroll
    for (int i = 0; i < 4; ++i) {
      const int cidx = i * 256 + lane * 4;
      float4 wv = *(const float4*)(w + cidx);
      float4 sc = *(const float4*)(mv + sc_off + cidx);
      float4 sh = *(const float4*)(mv + sh_off + cidx);
      float o0 = v[i].x * rstd * wv.x * (1.f + sc.x) + sh.x;
      float o1 = v[i].y * rstd * wv.y * (1.f + sc.y) + sh.y;
      float o2 = v[i].z * rstd * wv.z * (1.f + sc.z) + sh.z;
      float o3 = v[i].w * rstd * wv.w * (1.f + sc.w) + sh.w;
      uint2 pk; pk.x = pack2(o0, o1); pk.y = pack2(o2, o3);
      *(uint2*)(dst + (size_t)r * 1024 + cidx) = pk;
    }
  }
}

__device__ __forceinline__ void phase_final_norm(const float* __restrict__ src, const float* __restrict__ w, float* __restrict__ dst) {
  const int lane = threadIdx.x & 63, wid = threadIdx.x >> 6;
  for (int r = blockIdx.x * 4 + wid; r < ROWS_L; r += gridDim.x * 4) {
    const float* s = src + (size_t)r * 1024;
    float4 v[4];
    float ss = 0.f;
#pragma unroll
    for (int i = 0; i < 4; ++i) {
      v[i] = *(const float4*)(s + i * 256 + lane * 4);
      ss += v[i].x * v[i].x + v[i].y * v[i].y + v[i].z * v[i].z + v[i].w * v[i].w;
    }
    ss = wave_sum(ss);
    const float rstd = rsqrtf(ss * (1.f / 1024.f) + 1e-6f);
#pragma unroll
    for (int i = 0; i < 4; ++i) {
      const int cidx = i * 256 + lane * 4;
      float4 wv = *(const float4*)(w + cidx);
      float4 o; o.x = v[i].x * rstd * wv.x; o.y = v[i].y * rstd * wv.y; o.z = v[i].z * rstd * wv.z; o.w = v[i].w * rstd * wv.w;
      *(float4*)(dst + (size_t)r * 1024 + cidx) = o;
    }
  }
}

struct Epi {
  bf16_t* C; int ldc; int gelu_cols;
  const float* src_lat; const float* src_ctx;
  float* dst;
  const float* gate;
};

template <int EPI>
__device__ __forceinline__ void gemm_phase(const bf16_t* __restrict__ A, int lda, const bf16_t* __restrict__ Bt, int K, int Mrows, int N,
                           char* smem, const Epi ep) {
  const int tid = threadIdx.x, lane = tid & 63, wid = tid >> 6, wm = wid >> 1, wn = wid & 1;
  const int fr = lane & 15, fq = lane >> 4;
  const int srow = tid >> 3, skc = tid & 7;
  const int nMt = Mrows / 128, nNt = N / 128, ntiles = nMt * nNt, nk = K / 64;
  const int wofs = srow * 128 + ((skc ^ (srow & 7)) * 16);
  const int vb = (int)(blockIdx.x & 7u) * (int)(gridDim.x >> 3) + (int)(blockIdx.x >> 3);
  for (int tile = vb; tile < ntiles; tile += gridDim.x) {
    const int grp = tile / (8 * nNt), wi = tile % (8 * nNt);
    const int mt = grp * 8 + (wi & 7), nt = wi >> 3;
    const int m0 = mt * 128, n0 = nt * 128;
    f32x4 acc[4][4];
#pragma unroll
    for (int i = 0; i < 4; ++i)
#pragma unroll
      for (int j = 0; j < 4; ++j) acc[i][j] = (f32x4){0.f, 0.f, 0.f, 0.f};
    const bf16_t* ga = A + (size_t)(m0 + srow) * lda + skc * 8;
    const bf16_t* gb = Bt + (size_t)(n0 + srow) * K + skc * 8;
    const int drow = lane >> 3, dkc = (lane & 7) ^ (lane >> 3);
    const bf16_t* gA = A + (size_t)(m0 + wid * 32 + drow) * lda + dkc * 8;
    const bf16_t* gB = Bt + (size_t)(n0 + wid * 32 + drow) * K + dkc * 8;
    auto dma_tile = [&](int kt_, int buf_) {
#pragma unroll
      for (int i = 0; i < 4; ++i) {
        __builtin_amdgcn_global_load_lds((const unsigned*)(gA + (size_t)i * 8 * lda + kt_ * 64),
                                         (unsigned*)(smem + buf_ * 16384 + (wid * 4 + i) * 1024 + lane * 16), 16, 0, 0);
        __builtin_amdgcn_global_load_lds((const unsigned*)(gB + (size_t)i * 8 * K + kt_ * 64),
                                         (unsigned*)(smem + 32768 + buf_ * 16384 + (wid * 4 + i) * 1024 + lane * 16), 16, 0, 0);
      }
    };
    auto t_compute = [&](int buf_) {
      const char* as = smem + buf_ * 16384 + (wm * 64 + fr) * 128;
      const char* bs = smem + 32768 + buf_ * 16384 + (wn * 64 + fr) * 128;
      const int ko0 = ((fq) ^ (fr & 7)) * 16, ko1 = ((4 + fq) ^ (fr & 7)) * 16;
      bf16x8 af0[4], bf0[4], af1[4], bf1[4];
#pragma unroll
      for (int i = 0; i < 4; ++i) af0[i] = *(const bf16x8*)(as + i * 2048 + ko0);
#pragma unroll
      for (int j = 0; j < 4; ++j) bf0[j] = *(const bf16x8*)(bs + j * 2048 + ko0);
#pragma unroll
      for (int i = 0; i < 4; ++i) af1[i] = *(const bf16x8*)(as + i * 2048 + ko1);
#pragma unroll
      for (int j = 0; j < 4; ++j) bf1[j] = *(const bf16x8*)(bs + j * 2048 + ko1);
      __builtin_amdgcn_sched_barrier(0);
      __builtin_amdgcn_s_setprio(1);
#pragma unroll
      for (int i = 0; i < 4; ++i)
#pragma unroll
        for (int j = 0; j < 4; ++j) acc[i][j] = __builtin_amdgcn_mfma_f32_16x16x32_bf16(bf0[j], af0[i], acc[i][j], 0, 0, 0);
#pragma unroll
      for (int i = 0; i < 4; ++i)
#pragma unroll
        for (int j = 0; j < 4; ++j) acc[i][j] = __builtin_amdgcn_mfma_f32_16x16x32_bf16(bf1[j], af1[i], acc[i][j], 0, 0, 0);
      __builtin_amdgcn_s_setprio(0);
      __builtin_amdgcn_sched_barrier(0);
    };
    dma_tile(0, 0);
    asm volatile("s_waitcnt vmcnt(0)" ::: "memory");
    __syncthreads();
    for (int kt = 0; kt < nk; ++kt) {
      const int buf = kt & 1;
      if (kt + 1 < nk) dma_tile(kt + 1, buf ^ 1);
      t_compute(buf);
      asm volatile("s_waitcnt vmcnt(0)" ::: "memory");
      __syncthreads();
    }
    if (EPI == 0) {
      const bool do_gelu = n0 < ep.gelu_cols;
#pragma unroll
      for (int i = 0; i < 4; ++i) {
        const int m = m0 + wm * 64 + i * 16 + fr;
#pragma unroll
        for (int j = 0; j < 4; ++j) {
          const int n = n0 + wn * 64 + j * 16 + fq * 4;
          f32x4 v = acc[i][j];
          if (do_gelu) { v[0] = geluf_(v[0]); v[1] = geluf_(v[1]); v[2] = geluf_(v[2]); v[3] = geluf_(v[3]); }
          uint2 pk; pk.x = pack2(v[0], v[1]); pk.y = pack2(v[2], v[3]);
          *(uint2*)(ep.C + (size_t)m * ep.ldc + n) = pk;
        }
      }
    } else if (EPI == 1) {
      const int vec = (m0 < ROWS_L) ? (m0 >> 12) : 8;
      const float* gv = ep.gate + (size_t)vec * MODN;
#pragma unroll
      for (int i = 0; i < 4; ++i) {
        const int m = m0 + wm * 64 + i * 16 + fr;
        const float* srow_p = (m < ROWS_L) ? ep.src_lat + (size_t)m * 1024 : ep.src_ctx + (size_t)(m - ROWS_L) * 1024;
#pragma unroll
        for (int j = 0; j < 4; ++j) {
          const int n = n0 + wn * 64 + j * 16 + fq * 4;
          float4 sv = *(const float4*)(srow_p + n);
          float4 g = *(const float4*)(gv + n);
          float4 o;
          o.x = sv.x + g.x * acc[i][j][0]; o.y = sv.y + g.y * acc[i][j][1];
          o.z = sv.z + g.z * acc[i][j][2]; o.w = sv.w + g.w * acc[i][j][3];
          *(float4*)(ep.dst + (size_t)m * 1024 + n) = o;
        }
      }
    } else {
#pragma unroll
      for (int i = 0; i < 4; ++i) {
        const int m = m0 + wm * 64 + i * 16 + fr;
#pragma unroll
        for (int j = 0; j < 2; ++j) {
          const int n = (n0 >> 1) + wn * 32 + j * 16 + fq * 4;
          f32x4 g = acc[i][j], u = acc[i][j + 2];
          uint2 pk;
          pk.x = pack2(siluf_(g[0]) * u[0], siluf_(g[1]) * u[1]);
          pk.y = pack2(siluf_(g[2]) * u[2], siluf_(g[3]) * u[3]);
          *(uint2*)(ep.C + (size_t)m * ep.ldc + n) = pk;
        }
      }
    }
  }
}

__device__ __forceinline__ void sgu_item(const Params& p, int ck, int g, const bf16_t* __restrict__ pb, bf16_t* __restrict__ mix, char* smem) {
  constexpr int LDV = 136;
  bf16_t* vnT = (bf16_t*)smem;
  int tid = threadIdx.x;
  asm volatile("" : "+v"(tid));
  const int r0 = ck * 128;
  {
    const int q = tid >> 1, half = tid & 1;
    const bf16_t* vrow = pb + (size_t)(r0 + q) * NIN0 + 512 + half * 256;
    float ss = 0.f;
#pragma unroll 4
    for (int i = 0; i < 32; ++i) {
      uint4 u = *(const uint4*)(vrow + i * 8);
      float a;
      a = lo_bf(u.x); ss += a * a; a = hi_bf(u.x); ss += a * a;
      a = lo_bf(u.y); ss += a * a; a = hi_bf(u.y); ss += a * a;
      a = lo_bf(u.z); ss += a * a; a = hi_bf(u.z); ss += a * a;
      a = lo_bf(u.w); ss += a * a; a = hi_bf(u.w); ss += a * a;
    }
    ss += __shfl_xor(ss, 1);
    const float rstd = rsqrtf(ss * (1.f / 512.f) + 1e-6f);
    const bf16_t* vg = pb + (size_t)(r0 + q) * NIN0 + 512 + g * 128 + half * 64;
    const float* nw = p.ab_sgu_norm_w + g * 128 + half * 64;
#pragma unroll 2
    for (int i = 0; i < 8; ++i) {
      const uint4 u = *(const uint4*)(vg + i * 8);
      const float4 w0 = *(const float4*)(nw + i * 8), w1 = *(const float4*)(nw + i * 8 + 4);
      bf16_t* dp = vnT + (half * 64 + i * 8) * LDV + q;
      dp[0 * LDV] = f2bf(lo_bf(u.x) * rstd * w0.x); dp[1 * LDV] = f2bf(hi_bf(u.x) * rstd * w0.y);
      dp[2 * LDV] = f2bf(lo_bf(u.y) * rstd * w0.z); dp[3 * LDV] = f2bf(hi_bf(u.y) * rstd * w0.w);
      dp[4 * LDV] = f2bf(lo_bf(u.z) * rstd * w1.x); dp[5 * LDV] = f2bf(hi_bf(u.z) * rstd * w1.y);
      dp[6 * LDV] = f2bf(lo_bf(u.w) * rstd * w1.z); dp[7 * LDV] = f2bf(hi_bf(u.w) * rstd * w1.w);
    }
  }
  __syncthreads();
  {
    const int lane = tid & 63, wv = tid >> 6, fr = lane & 15, fq = lane >> 4;
    const float* W = p.ab_sgu_w + (size_t)g * 128 * 128;
    f32x4 acc[2][8];
#pragma unroll
    for (int i = 0; i < 2; ++i)
#pragma unroll
      for (int j = 0; j < 8; ++j) acc[i][j] = (f32x4){0.f, 0.f, 0.f, 0.f};
#pragma unroll
    for (int s4 = 0; s4 < 4; ++s4) {
      bf16x8 af[2];
#pragma unroll
      for (int i = 0; i < 2; ++i) {
        const float* wp = W + (wv * 32 + i * 16 + fr) * 128 + s4 * 32 + fq * 8;
        const float4 a0 = *(const float4*)wp, a1 = *(const float4*)(wp + 4);
        uint4 pk; pk.x = pack2(a0.x, a0.y); pk.y = pack2(a0.z, a0.w); pk.z = pack2(a1.x, a1.y); pk.w = pack2(a1.z, a1.w);
        af[i] = *(bf16x8*)&pk;
      }
#pragma unroll
      for (int j = 0; j < 8; ++j) {
        const bf16x8 bfr = *(const bf16x8*)(vnT + (j * 16 + fr) * LDV + s4 * 32 + fq * 8);
        acc[0][j] = __builtin_amdgcn_mfma_f32_16x16x32_bf16(bfr, af[0], acc[0][j], 0, 0, 0);
        acc[1][j] = __builtin_amdgcn_mfma_f32_16x16x32_bf16(bfr, af[1], acc[1][j], 0, 0, 0);
      }
    }
#pragma unroll
    for (int i = 0; i < 2; ++i) {
      const int pp = wv * 32 + i * 16 + fr;
      const float bias = p.ab_sgu_b[g * 128 + pp];
#pragma unroll
      for (int j = 0; j < 8; ++j) {
        const int cc = j * 16 + fq * 4;
        const uint2 uu = *(const uint2*)(pb + (size_t)(r0 + pp) * NIN0 + g * 128 + cc);
        uint2 pk;
        pk.x = pack2(lo_bf(uu.x) * (acc[i][j][0] + bias), hi_bf(uu.x) * (acc[i][j][1] + bias));
        pk.y = pack2(lo_bf(uu.y) * (acc[i][j][2] + bias), hi_bf(uu.y) * (acc[i][j][3] + bias));
        *(uint2*)(mix + (size_t)(r0 + pp) * 1024 + g * 128 + cc) = pk;
      }
    }
  }
  __syncthreads();
}

__device__ __forceinline__ void attn_item(const Params& p, bool latent, int b, int rq, int h, const bf16_t* __restrict__ pb, bf16_t* __restrict__ mix, char* smem) {
  int tid = threadIdx.x;
  asm volatile("" : "+v"(tid));
  const int lane = tid & 63, wv = tid >> 6, fr = lane & 15, fq = lane >> 4;
  const int qcol = wv * 16 + fr;
  const int qrow = latent ? (b * 4096 + rq * 64 + qcol) : (ROWS_L + b * 256 + rq * 64 + qcol);
  const int nnb = latent ? 8 : 0, nblk = nnb + 4;
  const int row_start = min(max(rq - 4, 0), 56);
  const int col_start = min(max(qcol - 8, 0), 48);
  const int kc0 = min(max(wv * 16 - 8, 0), 32);
  bf16x8 qf[2];
#pragma unroll
  for (int s2 = 0; s2 < 2; ++s2) {
    const uint4 u = *(const uint4*)(pb + (size_t)qrow * NIN0 + 1024 + h * 64 + s2 * 32 + fq * 8);
    uint4 v;
    v.x = pack2(lo_bf(u.x) * 0.125f, hi_bf(u.x) * 0.125f); v.y = pack2(lo_bf(u.y) * 0.125f, hi_bf(u.y) * 0.125f);
    v.z = pack2(lo_bf(u.z) * 0.125f, hi_bf(u.z) * 0.125f); v.w = pack2(lo_bf(u.w) * 0.125f, hi_bf(u.w) * 0.125f);
    qf[s2] = *(bf16x8*)&v;
  }
  f32x4 o[4];
#pragma unroll
  for (int dt = 0; dt < 4; ++dt) o[dt] = (f32x4){0.f, 0.f, 0.f, 0.f};
  float mrow = -1e30f, lsum = 0.f;
  uint4 rk[2], rv[2];
  auto blk_row = [&](int kb) -> int { return (kb < nnb) ? (b * 4096 + (row_start + kb) * 64) : (ROWS_L + b * 256 + (kb - nnb) * 64); };
  auto gload = [&](int kb) {
    const int r0 = blk_row(kb);
#pragma unroll
    for (int i = 0; i < 2; ++i) {
      const int sidx = tid + i * 256, key = sidx & 63, c8 = sidx >> 6;
      const bf16_t* rp = pb + (size_t)(r0 + key) * NIN0 + h * 64 + c8 * 8;
      rk[i] = *(const uint4*)(rp + 1536);
      rv[i] = *(const uint4*)(rp + 2048);
    }
  };
  auto lstore = [&](int buf) {
    bf16_t* kb_ = (bf16_t*)(smem + buf * 18432);
    bf16_t* vt_ = (bf16_t*)(smem + buf * 18432 + 9216);
#pragma unroll
    for (int i = 0; i < 2; ++i) {
      const int sidx = tid + i * 256, key = sidx & 63, c8 = sidx >> 6;
      *(uint4*)(kb_ + key * LDK + c8 * 8) = rk[i];
      bf16_t* dp = vt_ + (c8 * 8) * LDK + key;
      const uint4 u = rv[i];
      dp[0 * LDK] = (bf16_t)(u.x & 0xffff); dp[1 * LDK] = (bf16_t)(u.x >> 16);
      dp[2 * LDK] = (bf16_t)(u.y & 0xffff); dp[3 * LDK] = (bf16_t)(u.y >> 16);
      dp[4 * LDK] = (bf16_t)(u.z & 0xffff); dp[5 * LDK] = (bf16_t)(u.z >> 16);
      dp[6 * LDK] = (bf16_t)(u.w & 0xffff); dp[7 * LDK] = (bf16_t)(u.w >> 16);
    }
  };
  gload(0);
  lstore(0);
  __syncthreads();
  for (int kb = 0; kb < nblk; ++kb) {
    const int buf = kb & 1;
    if (kb + 1 < nblk) gload(kb + 1);
    const bf16_t* kbuf = (const bf16_t*)(smem + buf * 18432);
    const bf16_t* vtb = (const bf16_t*)(smem + buf * 18432 + 9216);
    const bool nb = kb < nnb;
    const int k0 = nb ? kc0 : 0;
    const int ntile = nb ? 2 : 4;
    f32x4 sc[4];
#pragma unroll
    for (int j = 0; j < 4; ++j) sc[j] = (f32x4){0.f, 0.f, 0.f, 0.f};
#pragma unroll
    for (int j = 0; j < 4; ++j) {
      if (j < ntile) {
#pragma unroll
        for (int s2 = 0; s2 < 2; ++s2) {
          const bf16x8 kf = *(const bf16x8*)(kbuf + (k0 + j * 16 + fr) * LDK + s2 * 32 + fq * 8);
          sc[j] = __builtin_amdgcn_mfma_f32_16x16x32_bf16(kf, qf[s2], sc[j], 0, 0, 0);
        }
      }
    }
    float bm = -1e30f;
    if (nb) {
      const int dr = row_start + kb - rq + 7;
      const float* bp = p.ab_rel_bias + (h * 15 + dr) * 31 + 15 - qcol;
#pragma unroll
      for (int j = 0; j < 2; ++j)
#pragma unroll
        for (int r = 0; r < 4; ++r) {
          const int kc = k0 + j * 16 + fq * 4 + r;
          const bool ok = (kc >= col_start) && (kc < col_start + 16);
          const float v = ok ? sc[j][r] + bp[ok ? kc : qcol] : -1e30f;
          sc[j][r] = v;
          bm = fmaxf(bm, v);
        }
    } else {
#pragma unroll
      for (int j = 0; j < 4; ++j)
#pragma unroll
        for (int r = 0; r < 4; ++r) bm = fmaxf(bm, sc[j][r]);
    }
    bm = fmaxf(bm, __shfl_xor(bm, 16));
    bm = fmaxf(bm, __shfl_xor(bm, 32));
    const float mnew = fmaxf(mrow, bm);
    const float corr = __expf(mrow - mnew);
    mrow = mnew;
    float ps = 0.f;
#pragma unroll
    for (int j = 0; j < 4; ++j)
#pragma unroll
      for (int r = 0; r < 4; ++r) {
        const float pe = (j < ntile) ? __expf(sc[j][r] - mnew) : 0.f;
        sc[j][r] = pe;
        ps += pe;
      }
    lsum = lsum * corr + ps;
#pragma unroll
    for (int dt = 0; dt < 4; ++dt) { o[dt][0] *= corr; o[dt][1] *= corr; o[dt][2] *= corr; o[dt][3] *= corr; }
#pragma unroll
    for (int jp = 0; jp < 2; ++jp) {
      if (jp * 2 < ntile) {
        uint4 pk;
        pk.x = pack2(sc[2 * jp][0], sc[2 * jp][1]); pk.y = pack2(sc[2 * jp][2], sc[2 * jp][3]);
        pk.z = pack2(sc[2 * jp + 1][0], sc[2 * jp + 1][1]); pk.w = pack2(sc[2 * jp + 1][2], sc[2 * jp + 1][3]);
        const bf16x8 pf = *(bf16x8*)&pk;
#pragma unroll
        for (int dt = 0; dt < 4; ++dt) {
          const bf16_t* vp = vtb + (dt * 16 + fr) * LDK + k0 + jp * 32 + fq * 4;
          uint4 vv;
          const uint2 lo = *(const uint2*)vp, hi = *(const uint2*)(vp + 16);
          vv.x = lo.x; vv.y = lo.y; vv.z = hi.x; vv.w = hi.y;
          o[dt] = __builtin_amdgcn_mfma_f32_16x16x32_bf16(*(bf16x8*)&vv, pf, o[dt], 0, 0, 0);
        }
      }
    }
    if (kb + 1 < nblk) lstore(buf ^ 1);
    __syncthreads();
  }
  lsum += __shfl_xor(lsum, 16);
  lsum += __shfl_xor(lsum, 32);
  const float inv = 1.f / lsum;
#pragma unroll
  for (int dt = 0; dt < 4; ++dt) {
    uint2 pk; pk.x = pack2(o[dt][0] * inv, o[dt][1] * inv); pk.y = pack2(o[dt][2] * inv, o[dt][3] * inv);
    *(uint2*)(mix + (size_t)qrow * 1024 + 512 + h * 64 + dt * 16 + fq * 4) = pk;
  }
}

__device__ __forceinline__ void phase_mix0(const Params& p, char* smem) {
  const bf16_t* pb = (const bf16_t*)(p.ws + OFF_BIG);
  bf16_t* mix = (bf16_t*)(p.ws + OFF_HM);
  const int n_sgu = 272 * 4, n_al = 8 * 64 * 8, n_ac = 8 * 4 * 8;
  const int total = n_sgu + n_al + n_ac;
  for (int it = blockIdx.x; it < total; it += gridDim.x) {
    if (it < n_al) { int t = it; attn_item(p, true, t >> 9, (t >> 3) & 63, t & 7, pb, mix, smem); }
    else if (it < n_al + n_ac) { int t = it - n_al; attn_item(p, false, t >> 5, (t >> 3) & 3, t & 7, pb, mix, smem); }
    else { int t = it - n_al - n_ac; sgu_item(p, t >> 2, t & 3, pb, mix, smem); }
  }
}


constexpr size_t OFF_DEC = OFF_BIG + 177 * MiB;
template <int NJ>
__device__ __forceinline__ void wave_mma_lds(const bf16_t* A, const bf16_t* Bt, f32x4 (&acc)[NJ], int fr, int fq) {
#pragma unroll
  for (int s = 0; s < 2; ++s) {
    const bf16x8 a = *(const bf16x8*)(A + fr * LDK + s * 32 + fq * 8);
#pragma unroll
    for (int j = 0; j < NJ; ++j) {
      const bf16x8 b = *(const bf16x8*)(Bt + (j * 16 + fr) * LDK + s * 32 + fq * 8);
      acc[j] = __builtin_amdgcn_mfma_f32_16x16x32_bf16(b, a, acc[j], 0, 0, 0);
    }
  }
}
template <int NJ>
__device__ __forceinline__ void wave_mma_glb(const bf16_t* A, const bf16_t* Btg, f32x4 (&acc)[NJ], int fr, int fq) {
#pragma unroll
  for (int s = 0; s < 2; ++s) {
    const bf16x8 a = *(const bf16x8*)(A + fr * LDK + s * 32 + fq * 8);
#pragma unroll
    for (int j = 0; j < NJ; ++j) {
      const bf16x8 b = *(const bf16x8*)(Btg + (j * 16 + fr) * 64 + s * 32 + fq * 8);
      acc[j] = __builtin_amdgcn_mfma_f32_16x16x32_bf16(b, a, acc[j], 0, 0, 0);
    }
  }
}

template <bool LATENT, bool WANT_OUT, bool WANT_KV>
__device__ __forceinline__ void gla_prep(const Params& p, const bf16_t* __restrict__ pb, int rbase, int h, int dir, int n, char* smem, float* decay_out) {
  bf16_t* kraw = (bf16_t*)smem;
  bf16_t* qraw = (bf16_t*)(smem + 8192);
  float* tot = (float*)(smem + 16384);
  bf16_t* qe = (bf16_t*)(smem + 17408);
  bf16_t* kinv = (bf16_t*)(smem + 26624);
  bf16_t* kdecT = (bf16_t*)(smem + 35840);
  const float* tab = (const float*)(p.ws + OFF_TAB);
  int tid = threadIdx.x;
  asm volatile("" : "+v"(tid));
  const int d = tid & 63, lq = tid >> 6;
#pragma unroll
  for (int i = 0; i < 2; ++i) {
    const int idx = tid + i * 256, l = idx >> 3, c8 = idx & 7;
    const bf16_t* rp = pb + (size_t)(rbase + l) * NIN1P + h * 64 + c8 * 8;
    *(uint4*)(kraw + l * 64 + c8 * 8) = *(const uint4*)(rp + 768);
    if (WANT_OUT) *(uint4*)(qraw + l * 64 + c8 * 8) = *(const uint4*)(rp + 512);
  }
  bf16_t* araw = (bf16_t*)(smem + 63488);
  if (tid < 128) {
    const int l = tid >> 1, hf = tid & 1;
    *(uint4*)(araw + l * 16 + hf * 8) = *(const uint4*)(pb + (size_t)(rbase + l) * NIN1P + 2048 + dir * 16 + hf * 8);
  }
  const float* dw = dir ? p.cd_dw_b : p.cd_dw_f;
  const float* db = dir ? p.cd_db_b : p.cd_db_f;
  float w[16];
#pragma unroll
  for (int j = 0; j < 16; ++j) w[j] = dw[j * 256 + h * 64 + d];
  const float bias = db[h * 64 + d];
  float c[16];
  __syncthreads();
#pragma unroll
  for (int i = 0; i < 16; ++i) {
    const bf16_t* ap = araw + (lq * 16 + i) * 16;
    const uint4 u0 = *(const uint4*)ap, u1 = *(const uint4*)(ap + 8);
    float x = bias;
    x += lo_bf(u0.x) * w[0] + hi_bf(u0.x) * w[1] + lo_bf(u0.y) * w[2] + hi_bf(u0.y) * w[3];
    x += lo_bf(u0.z) * w[4] + hi_bf(u0.z) * w[5] + lo_bf(u0.w) * w[6] + hi_bf(u0.w) * w[7];
    x += lo_bf(u1.x) * w[8] + hi_bf(u1.x) * w[9] + lo_bf(u1.y) * w[10] + hi_bf(u1.y) * w[11];
    x += lo_bf(u1.z) * w[12] + hi_bf(u1.z) * w[13] + lo_bf(u1.w) * w[14] + hi_bf(u1.w) * w[15];
    c[i] = (fminf(x, 0.f) - __logf(1.f + __expf(-fabsf(x)))) * (1.f / 16.f);
    __builtin_amdgcn_sched_barrier(0);
  }
  if (dir == 0) {
#pragma unroll
    for (int i = 1; i < 16; ++i) c[i] += c[i - 1];
    tot[lq * 64 + d] = c[15];
  } else {
#pragma unroll
    for (int i = 14; i >= 0; --i) c[i] += c[i + 1];
    tot[lq * 64 + d] = c[0];
  }
  __syncthreads();
  const float t0 = tot[d], t1 = tot[64 + d], t2 = tot[128 + d], t3 = tot[192 + d];
  const float ctot = (t0 + t1) + (t2 + t3);
  float off;
  if (dir == 0) off = (lq > 0 ? t0 : 0.f) + (lq > 1 ? t1 : 0.f) + (lq > 2 ? t2 : 0.f);
  else off = (lq < 3 ? t3 : 0.f) + (lq < 2 ? t2 : 0.f) + (lq < 1 ? t1 : 0.f);
  float kd_prev = 0.f;
#pragma unroll
  for (int i = 0; i < 16; ++i) {
    const int l = lq * 16 + i;
    const float cc = c[i] + off;
    float kv = bf2f(kraw[l * 64 + d]);
    float qv = WANT_OUT ? bf2f(qraw[l * 64 + d]) : 0.f;
    if (LATENT) {
      const float kp = bf2f(kraw[l * 64 + (d ^ 16)]);
      const int pos = (d < 32) ? n : l;
      const float cs = tab[8576 + pos * 16 + (d & 15)], sn = tab[9600 + pos * 16 + (d & 15)];
      const float sg = (d & 16) ? sn : -sn;
      kv = kv * cs + kp * sg;
      if (WANT_OUT) { const float qp = bf2f(qraw[l * 64 + (d ^ 16)]); qv = qv * cs + qp * sg; }
    }
    if (WANT_OUT) {
      qe[l * LDK + d] = f2bf(qv * 0.125f * __expf(cc));
      kinv[l * LDK + d] = f2bf(kv * __expf(-cc));
    }
    if (WANT_KV) {
      const float kd = kv * __expf(ctot - cc);
      if (i & 1) *(unsigned*)(kdecT + d * LDK + l - 1) = pack2(kd_prev, kd);
      kd_prev = kd;
    }
    __builtin_amdgcn_sched_barrier(0);
  }
  if (WANT_KV && lq == 0) decay_out[d] = __expf(ctot);
}

__device__ __forceinline__ void gla_stage_vT(const bf16_t* __restrict__ pb, int rbase, int h, char* smem) {
  bf16_t* vT = (bf16_t*)(smem + 45056);
  const int tid = threadIdx.x;
#pragma unroll
  for (int i = 0; i < 4; ++i) {
    const int idx = tid + i * 256, l = idx & 63, e8 = idx >> 6;
    const uint4 u = *(const uint4*)(pb + (size_t)(rbase + l) * NIN1P + 1024 + h * 128 + e8 * 8);
    bf16_t* dp = vT + (e8 * 8) * LDK + l;
    dp[0 * LDK] = (bf16_t)(u.x & 0xffff); dp[1 * LDK] = (bf16_t)(u.x >> 16);
    dp[2 * LDK] = (bf16_t)(u.y & 0xffff); dp[3 * LDK] = (bf16_t)(u.y >> 16);
    dp[4 * LDK] = (bf16_t)(u.z & 0xffff); dp[5 * LDK] = (bf16_t)(u.z >> 16);
    dp[6 * LDK] = (bf16_t)(u.w & 0xffff); dp[7 * LDK] = (bf16_t)(u.w >> 16);
  }
}

__device__ __forceinline__ void gla_kv_item(const Params& p, int b, int h, int dir, int j, const bf16_t* __restrict__ pb, char* smem) {
  const int sidx = ((b * 4 + h) * 2 + dir) * 68 + j;
  bf16_t* slot = (bf16_t*)(p.ws + OFF_EXTRA) + (size_t)sidx * 8192;
  float* dec = (float*)(p.ws + OFF_DEC) + (size_t)sidx * 64;
  int rbase;
  if (j < 4) {
    const int nc = dir ? 3 - j : j;
    rbase = ROWS_L + b * 256 + nc * 64;
    gla_prep<false, false, true>(p, pb, rbase, h, dir, 0, smem, dec);
  } else {
    const int jj = j - 4, n = dir ? 63 - jj : jj;
    rbase = b * 4096 + n * 64;
    gla_prep<true, false, true>(p, pb, rbase, h, dir, n, smem, dec);
  }
  gla_stage_vT(pb, rbase, h, smem);
  __syncthreads();
  const bf16_t* kdecT = (const bf16_t*)(smem + 35840);
  const bf16_t* vT = (const bf16_t*)(smem + 45056);
  const int lane = threadIdx.x & 63, wv = threadIdx.x >> 6, fr = lane & 15, fq = lane >> 4;
#pragma unroll
  for (int i2 = 0; i2 < 2; ++i2) {
    f32x4 acc[4];
#pragma unroll
    for (int jn = 0; jn < 4; ++jn) acc[jn] = (f32x4){0.f, 0.f, 0.f, 0.f};
    wave_mma_lds<4>(vT + (wv * 32 + i2 * 16) * LDK, kdecT, acc, fr, fq);
    const int e = wv * 32 + i2 * 16 + fr;
#pragma unroll
    for (int jn = 0; jn < 4; ++jn) {
      uint2 pk; pk.x = pack2(acc[jn][0], acc[jn][1]); pk.y = pack2(acc[jn][2], acc[jn][3]);
      *(uint2*)(slot + e * 64 + jn * 16 + fq * 4) = pk;
    }
  }
  __syncthreads();
}

__device__ __forceinline__ void gla_scan_item(const Params& p, int bhd, int es) {
  const int tid = threadIdx.x, e = es * 32 + (tid >> 3), d0 = (tid & 7) * 8;
  bf16_t* base = (bf16_t*)(p.ws + OFF_EXTRA) + (size_t)bhd * 68 * 8192 + e * 64 + d0;
  const float* dec = (const float*)(p.ws + OFF_DEC) + (size_t)bhd * 68 * 64 + d0;
  float s[8];
#pragma unroll
  for (int k = 0; k < 8; ++k) s[k] = 0.f;
#pragma unroll 4
  for (int j = 0; j < 68; ++j) {
    const uint4 u = *(const uint4*)(base + (size_t)j * 8192);
    const float4 da = *(const float4*)(dec + j * 64), dbb = *(const float4*)(dec + j * 64 + 4);
#ifndef SCAN_NOSTORE
    if (j >= 4) {
      uint4 o; o.x = pack2(s[0], s[1]); o.y = pack2(s[2], s[3]); o.z = pack2(s[4], s[5]); o.w = pack2(s[6], s[7]);
      *(uint4*)(base + (size_t)j * 8192) = o;
    }
#endif
    s[0] = da.x * s[0] + lo_bf(u.x); s[1] = da.y * s[1] + hi_bf(u.x); s[2] = da.z * s[2] + lo_bf(u.y); s[3] = da.w * s[3] + hi_bf(u.y);
    s[4] = dbb.x * s[4] + lo_bf(u.z); s[5] = dbb.y * s[5] + hi_bf(u.z); s[6] = dbb.z * s[6] + lo_bf(u.w); s[7] = dbb.w * s[7] + hi_bf(u.w);
  }
#ifdef SCAN_NOSTORE
  { float* o = p.out + ((size_t)bhd * 128 + e) * 64 + d0;
#pragma unroll
    for (int k = 0; k < 8; ++k) o[k] = s[k]; }
#endif
}

__device__ __forceinline__ void gla_out_item(const Params& p, int b, int h, int n, const bf16_t* __restrict__ pb, bf16_t* __restrict__ mix, char* smem) {
  const int rbase = b * 4096 + n * 64;
  const bf16_t* qe = (const bf16_t*)(smem + 17408);
  const bf16_t* kinv = (const bf16_t*)(smem + 26624);
  bf16_t* att = (bf16_t*)(smem + 35840);
  const bf16_t* vT = (const bf16_t*)(smem + 45056);
  int tid_ = threadIdx.x;
  asm volatile("" : "+v"(tid_));
  const int lane = tid_ & 63, wv = tid_ >> 6, fr = lane & 15, fq = lane >> 4;
  f32x4 o[8];
#pragma unroll
  for (int jn = 0; jn < 8; ++jn) o[jn] = (f32x4){0.f, 0.f, 0.f, 0.f};
  gla_stage_vT(pb, rbase, h, smem);
#pragma unroll 1
  for (int dir = 0; dir < 2; ++dir) {
    gla_prep<true, true, false>(p, pb, rbase, h, dir, n, smem, nullptr);
    __syncthreads();
    f32x4 a4[4];
#pragma unroll
    for (int jn = 0; jn < 4; ++jn) a4[jn] = (f32x4){0.f, 0.f, 0.f, 0.f};
    wave_mma_lds<4>(qe + wv * 16 * LDK, kinv, a4, fr, fq);
    const int row = wv * 16 + fr;
#pragma unroll
    for (int jn = 0; jn < 4; ++jn) {
      float v[4];
#pragma unroll
      for (int r = 0; r < 4; ++r) {
        const int col = jn * 16 + fq * 4 + r;
        const bool keep = dir ? (col >= row) : (col <= row);
        v[r] = keep ? a4[jn][r] : 0.f;
      }
      uint2 pk; pk.x = pack2(v[0], v[1]); pk.y = pack2(v[2], v[3]);
      *(uint2*)(att + row * LDK + jn * 16 + fq * 4) = pk;
    }
    __syncthreads();
    wave_mma_lds<8>(att + wv * 16 * LDK, vT, o, fr, fq);
    const int jj = dir ? 63 - n : n;
    const bf16_t* ST = (const bf16_t*)(p.ws + OFF_EXTRA) + (size_t)(((b * 4 + h) * 2 + dir) * 68 + 4 + jj) * 8192;
    wave_mma_glb<8>(qe + wv * 16 * LDK, ST, o, fr, fq);
    __syncthreads();
  }
  float ss = 0.f;
#pragma unroll
  for (int jn = 0; jn < 8; ++jn) ss += o[jn][0] * o[jn][0] + o[jn][1] * o[jn][1] + o[jn][2] * o[jn][2] + o[jn][3] * o[jn][3];
  ss += __shfl_xor(ss, 16);
  ss += __shfl_xor(ss, 32);
  const float rstd = rsqrtf(ss * (1.f / 128.f) + 1e-6f);
  const int trow = rbase + wv * 16 + fr;
#pragma unroll
  for (int jn = 0; jn < 8; ++jn) {
    const int e = jn * 16 + fq * 4;
    const uint2 gq = *(const uint2*)(pb + (size_t)trow * NIN1P + 1536 + h * 128 + e);
    const float4 hw = *(const float4*)(p.cd_head_norm_w + e);
    const float y0 = o[jn][0] * rstd * hw.x * siluf_(lo_bf(gq.x)), y1 = o[jn][1] * rstd * hw.y * siluf_(hi_bf(gq.x));
    const float y2 = o[jn][2] * rstd * hw.z * siluf_(lo_bf(gq.y)), y3 = o[jn][3] * rstd * hw.w * siluf_(hi_bf(gq.y));
    uint2 pk; pk.x = pack2(y0, y1); pk.y = pack2(y2, y3);
    *(uint2*)(mix + (size_t)trow * 1024 + 512 + h * 128 + e) = pk;
  }
}

__device__ __forceinline__ void fft1_item(const Params& p, int b, int g, int t2, const bf16_t* __restrict__ pb, char* smem) {
  bf16_t* GT = (bf16_t*)smem;
  const bf16_t* T1 = (const bf16_t*)(p.ws + OFF_TAB + 65536);
  const bf16_t* C64 = T1 + 32768;
  const bf16_t* S64 = C64 + 4096;
  const bf16_t* NS64 = C64 + 8192;
  const float* tab = (const float*)(p.ws + OFF_TAB);
  int tid = threadIdx.x;
  asm volatile("" : "+v"(tid));
  const int lane = tid & 63, wv = tid >> 6, fr = lane & 15, fq = lane >> 4;
  {
    f32x4 ga[16];
#pragma unroll
    for (int j = 0; j < 16; ++j) ga[j] = (f32x4){0.f, 0.f, 0.f, 0.f};
    const bf16_t* frow = pb + (size_t)(b * 4096 + (wv * 16 + fr) * 64 + t2) * NIN1P + g * 128 + fq * 8;
#pragma unroll
    for (int s4 = 0; s4 < 4; ++s4) {
      const bf16x8 af = *(const bf16x8*)(frow + s4 * 32);
#pragma unroll
      for (int j = 0; j < 16; ++j) {
        const bf16x8 bfr = *(const bf16x8*)(T1 + (j * 16 + fr) * 128 + s4 * 32 + fq * 8);
        ga[j] = __builtin_amdgcn_mfma_f32_16x16x32_bf16(bfr, af, ga[j], 0, 0, 0);
      }
    }
#pragma unroll
    for (int j = 0; j < 16; ++j)
#pragma unroll
      for (int r = 0; r < 4; ++r) GT[(j * 16 + fq * 4 + r) * LDK + wv * 16 + fr] = f2bf(ga[j][r]);
  }
  __syncthreads();
  {
    f32x4 ar[8], ai[8];
#pragma unroll
    for (int j = 0; j < 8; ++j) { ar[j] = (f32x4){0.f, 0.f, 0.f, 0.f}; ai[j] = (f32x4){0.f, 0.f, 0.f, 0.f}; }
    const int k1 = wv * 16 + fr;
#pragma unroll
    for (int s2 = 0; s2 < 2; ++s2) {
      const bf16x8 cf = *(const bf16x8*)(C64 + k1 * 64 + s2 * 32 + fq * 8);
      const bf16x8 sf = *(const bf16x8*)(S64 + k1 * 64 + s2 * 32 + fq * 8);
      const bf16x8 nsf = *(const bf16x8*)(NS64 + k1 * 64 + s2 * 32 + fq * 8);
#pragma unroll
      for (int j = 0; j < 8; ++j) {
        const bf16x8 grf = *(const bf16x8*)(GT + (j * 16 + fr) * LDK + s2 * 32 + fq * 8);
        const bf16x8 gif = *(const bf16x8*)(GT + (128 + j * 16 + fr) * LDK + s2 * 32 + fq * 8);
        ar[j] = __builtin_amdgcn_mfma_f32_16x16x32_bf16(grf, cf, ar[j], 0, 0, 0);
        ar[j] = __builtin_amdgcn_mfma_f32_16x16x32_bf16(gif, sf, ar[j], 0, 0, 0);
        ai[j] = __builtin_amdgcn_mfma_f32_16x16x32_bf16(gif, cf, ai[j], 0, 0, 0);
        ai[j] = __builtin_amdgcn_mfma_f32_16x16x32_bf16(grf, nsf, ai[j], 0, 0, 0);
      }
    }
    const int tw = k1 * t2;
    const float tc = tab[384 + tw], ts = tab[4480 + tw];
    bf16_t* apr = (bf16_t*)p.out + ((size_t)((b * 4 + g) * 64 + k1) * 64 + t2) * 128;
    bf16_t* api = apr + 16777216;
#pragma unroll
    for (int j = 0; j < 8; ++j) {
      uint2 pr, pi;
      pr.x = pack2(ar[j][0] * tc + ai[j][0] * ts, ar[j][1] * tc + ai[j][1] * ts);
      pr.y = pack2(ar[j][2] * tc + ai[j][2] * ts, ar[j][3] * tc + ai[j][3] * ts);
      pi.x = pack2(ai[j][0] * tc - ar[j][0] * ts, ai[j][1] * tc - ar[j][1] * ts);
      pi.y = pack2(ai[j][2] * tc - ar[j][2] * ts, ai[j][3] * tc - ar[j][3] * ts);
      *(uint2*)(apr + j * 16 + fq * 4) = pr;
      *(uint2*)(api + j * 16 + fq * 4) = pi;
    }
  }
  __syncthreads();
}

__device__ __forceinline__ void fft2_item(const Params& p, int b, int g, int k1, bf16_t* __restrict__ mix, char* smem) {
  bf16_t* ArT = (bf16_t*)smem;
  bf16_t* AiT = ArT + 128 * LDK;
  const bf16_t* C64 = (const bf16_t*)(p.ws + OFF_TAB + 65536) + 32768;
  const bf16_t* S64 = C64 + 4096;
  const bf16_t* apr = (const bf16_t*)p.out + (size_t)((b * 4 + g) * 64 + k1) * 64 * 128;
  const bf16_t* api = apr + 16777216;
  int tid = threadIdx.x;
  asm volatile("" : "+v"(tid));
#pragma unroll
  for (int i = 0; i < 4; ++i) {
    const int idx = tid + i * 256, t2 = idx & 63, m8 = idx >> 6;
    const uint4 u = *(const uint4*)(apr + t2 * 128 + m8 * 8);
    const uint4 v = *(const uint4*)(api + t2 * 128 + m8 * 8);
    bf16_t* dr = ArT + (m8 * 8) * LDK + t2;
    bf16_t* di = AiT + (m8 * 8) * LDK + t2;
    dr[0 * LDK] = (bf16_t)(u.x & 0xffff); dr[1 * LDK] = (bf16_t)(u.x >> 16); dr[2 * LDK] = (bf16_t)(u.y & 0xffff); dr[3 * LDK] = (bf16_t)(u.y >> 16);
    dr[4 * LDK] = (bf16_t)(u.z & 0xffff); dr[5 * LDK] = (bf16_t)(u.z >> 16); dr[6 * LDK] = (bf16_t)(u.w & 0xffff); dr[7 * LDK] = (bf16_t)(u.w >> 16);
    di[0 * LDK] = (bf16_t)(v.x & 0xffff); di[1 * LDK] = (bf16_t)(v.x >> 16); di[2 * LDK] = (bf16_t)(v.y & 0xffff); di[3 * LDK] = (bf16_t)(v.y >> 16);
    di[4 * LDK] = (bf16_t)(v.z & 0xffff); di[5 * LDK] = (bf16_t)(v.z >> 16); di[6 * LDK] = (bf16_t)(v.w & 0xffff); di[7 * LDK] = (bf16_t)(v.w >> 16);
  }
  __syncthreads();
  const int lane = tid & 63, wv = tid >> 6, fr = lane & 15, fq = lane >> 4;
  const int k2 = wv * 16 + fr;
  f32x4 x[8];
#pragma unroll
  for (int j = 0; j < 8; ++j) x[j] = (f32x4){0.f, 0.f, 0.f, 0.f};
#pragma unroll
  for (int s2 = 0; s2 < 2; ++s2) {
    const bf16x8 cf = *(const bf16x8*)(C64 + k2 * 64 + s2 * 32 + fq * 8);
    const bf16x8 sf = *(const bf16x8*)(S64 + k2 * 64 + s2 * 32 + fq * 8);
#pragma unroll
    for (int j = 0; j < 8; ++j) {
      const bf16x8 rf = *(const bf16x8*)(ArT + (j * 16 + fr) * LDK + s2 * 32 + fq * 8);
      const bf16x8 jf = *(const bf16x8*)(AiT + (j * 16 + fr) * LDK + s2 * 32 + fq * 8);
      x[j] = __builtin_amdgcn_mfma_f32_16x16x32_bf16(rf, cf, x[j], 0, 0, 0);
      x[j] = __builtin_amdgcn_mfma_f32_16x16x32_bf16(jf, sf, x[j], 0, 0, 0);
    }
  }
  const float scale = 0.0013810679320049757f;
  bf16_t* orow = mix + (size_t)(b * 4096 + k1 + 64 * k2) * 1024 + g * 128;
#pragma unroll
  for (int j = 0; j < 8; ++j) {
    uint2 pk; pk.x = pack2(x[j][0] * scale, x[j][1] * scale); pk.y = pack2(x[j][2] * scale, x[j][3] * scale);
    *(uint2*)(orow + j * 16 + fq * 4) = pk;
  }
  __syncthreads();
}

__device__ __forceinline__ void phase_mix1a(const Params& p, char* smem) {
  const bf16_t* pb = (const bf16_t*)(p.ws + OFF_BIG);
  const int n_kv = 64 * 68, n_f1 = 8 * 4 * 64;
  for (int it = blockIdx.x; it < n_kv + n_f1; it += gridDim.x) {
    if (it < n_kv) { const int bhd = it / 68, j = it % 68; gla_kv_item(p, bhd >> 3, (bhd >> 1) & 3, bhd & 1, j, pb, smem); }
    else { int t = it - n_kv; fft1_item(p, t >> 8, (t >> 6) & 3, t & 63, pb, smem); }
  }
}

__device__ __forceinline__ void phase_mix1b(const Params& p, char* smem) {
  bf16_t* mix = (bf16_t*)(p.ws + OFF_HM);
  const int n_scan = 256, n_f2 = 8 * 4 * 64;
  for (int it = blockIdx.x; it < n_scan + n_f2; it += gridDim.x) {
#ifndef NO_SCAN
    if (it < n_scan) gla_scan_item(p, it >> 2, it & 3); else
#endif
    { int t = it - n_scan; if (t >= 0) fft2_item(p, t >> 8, (t >> 6) & 3, t & 63, mix, smem); }
  }
}

__device__ __forceinline__ void phase_mix1c(const Params& p, char* smem) {
  const bf16_t* pb = (const bf16_t*)(p.ws + OFF_BIG);
  bf16_t* mix = (bf16_t*)(p.ws + OFF_HM);
  for (int it = blockIdx.x; it < 2048; it += gridDim.x) gla_out_item(p, it >> 8, (it >> 6) & 3, it & 63, pb, mix, smem);
}

#ifndef STOP_AFTER
#define STOP_AFTER 107
#define DUMP_OB 1.0f
#define DUMP_AP 0.0f
#endif
__device__ __forceinline__ void dump_bf16(const bf16_t* buf, int ld, int ncols, float* out) {
  for (size_t idx = (size_t)blockIdx.x * NT + threadIdx.x; idx < (size_t)ROWS_L * 1024; idx += (size_t)gridDim.x * NT) {
    const int r = (int)(idx >> 10), c = (int)(idx & 1023);
    float s = 0.f;
    for (int cc = c; cc < ncols; cc += 1024) {
      s += bf2f(buf[(size_t)r * ld + cc]);
      if (r < ROWS_C) s += bf2f(buf[(size_t)(r + ROWS_L) * ld + cc]);
    }
    out[idx] = s;
  }
}
__device__ __forceinline__ void dump_f32(const float* buf, float* out) {
  for (size_t idx = (size_t)blockIdx.x * NT + threadIdx.x; idx < (size_t)ROWS_L * 1024; idx += (size_t)gridDim.x * NT) {
    const int r = (int)(idx >> 10);
    float s = buf[idx];
    if (r < ROWS_C) s += buf[idx + (size_t)ROWS_L * 1024];
    out[idx] = s;
  }
}

#define XB_XCNT(j) (256 + 64 * (j))
#define XB_XSUB(j) (1280 + 64 * (j))
#define XB_XGEN(j) (2304 + 64 * (j))
#define XB_TOP 3328
#define XB_TOPGEN 3392
struct BarState { unsigned x, nloc, nx; };
__device__ __forceinline__ unsigned xb_ld(unsigned* p) { return __hip_atomic_load(p, __ATOMIC_RELAXED, __HIP_MEMORY_SCOPE_AGENT); }
__device__ __forceinline__ unsigned xb_add(unsigned* p, unsigned v) { return __hip_atomic_fetch_add(p, v, __ATOMIC_RELAXED, __HIP_MEMORY_SCOPE_AGENT); }
__device__ __forceinline__ void grid_barrier_post(unsigned* bar, BarState& st) {
  st.x = (unsigned)__builtin_amdgcn_s_getreg((3 << 11) | 20) & 0xFu;
  st.nloc = 0u; st.nx = 0u;
  if (threadIdx.x == 0) (void)xb_add(&bar[XB_XCNT(st.x)], 1u);
}
__device__ __forceinline__ void grid_barrier(unsigned* bar, BarState& st, const float*, float*) {
  asm volatile("s_waitcnt vmcnt(0) lgkmcnt(0)" ::: "memory");
  __syncthreads();
  if (threadIdx.x == 0) {
    if (st.nloc == 0u) {
      const unsigned G = gridDim.x;
      for (;;) {
        unsigned sum = 0u, cnt = 0u, mine = 0u;
#pragma unroll
        for (unsigned j = 0; j < 16; ++j) { const unsigned c = xb_ld(&bar[XB_XCNT(j)]); sum += c; cnt += (c > 0u) ? 1u : 0u; mine = (j == st.x) ? c : mine; }
        if (sum == G) { st.nloc = mine; st.nx = cnt; break; }
        __builtin_amdgcn_s_sleep(1);
      }
    }
    const unsigned old = xb_add(&bar[XB_XSUB(st.x)], 1u);
    const unsigned gen = old / st.nloc;
    if (old + 1u == (gen + 1u) * st.nloc) {
      __builtin_amdgcn_fence(__ATOMIC_RELEASE, "agent");
      asm volatile("s_waitcnt vmcnt(0)" ::: "memory");
      const unsigned og = xb_add(&bar[XB_TOP], 1u);
      const unsigned tg = og / st.nx;
      if (og + 1u == (tg + 1u) * st.nx) (void)xb_add(&bar[XB_TOPGEN], 1u);
      else while (xb_ld(&bar[XB_TOPGEN]) == tg) __builtin_amdgcn_s_sleep(1);
      __builtin_amdgcn_fence(__ATOMIC_ACQUIRE, "agent");
      (void)xb_add(&bar[XB_XGEN(st.x)], 1u);
      asm volatile("s_waitcnt vmcnt(0)" ::: "memory");
    } else {
      while (xb_ld(&bar[XB_XGEN(st.x)]) == gen) __builtin_amdgcn_s_sleep(1);
      __builtin_amdgcn_fence(__ATOMIC_ACQUIRE, "agent");
      asm volatile("s_waitcnt vmcnt(0)" ::: "memory");
    }
  }
  __syncthreads();
}

constexpr int NPHASE = 16;
#ifndef ONLY
#define ONLY -1
#endif
#define PH_EN(n) (ONLY < 0 || ONLY == (n))

template <int PH>
__device__ __forceinline__ void run_phase(const Params& p, char* smem) {
  const float* mod0 = (const float*)(p.ws + OFF_MOD);
  const float* mod1 = mod0 + 9 * MODN;
  float* xres = (float*)(p.ws + OFF_XRES);
  float* xctx = xres + (size_t)ROWS_L * 1024;
  bf16_t* hm = (bf16_t*)(p.ws + OFF_HM);
  bf16_t* big = (bf16_t*)(p.ws + OFF_BIG);
  if (PH == 0) phase_prep(p, smem);
  if (PH == 1) phase_norm(p.x, p.ctx, p.norm_mix_w, mod0, 0, 1024, hm, ROWS);
  if (PH == 2) { Epi e{}; e.C = big; e.ldc = NIN0; e.gelu_cols = 1024;
    gemm_phase<0>(hm, 1024, (const bf16_t*)(p.ws + OFF_WIN0), 1024, ROWS, NIN0, smem, e); }
  if (PH == 3) phase_mix0(p, smem);
  if (PH == 4) { Epi e{}; e.src_lat = p.x; e.src_ctx = p.ctx; e.dst = xres; e.gate = mod0 + 2048;
    gemm_phase<1>(hm, 1024, (const bf16_t*)(p.ws + OFF_WOUT0), 1024, ROWS, 1024, smem, e); }
  if (PH == 5) phase_norm(xres, xctx, p.norm_ffn_w, mod0, 3072, 4096, hm, ROWS);
  if (PH == 6) { Epi e{}; e.C = big; e.ldc = FFN;
    gemm_phase<2>(hm, 1024, (const bf16_t*)(p.ws + OFF_WGU0), 1024, ROWS, 2 * FFN, smem, e); }
  if (PH == 7) { Epi e{}; e.src_lat = xres; e.src_ctx = xctx; e.dst = xres; e.gate = mod0 + 5120;
    gemm_phase<1>(big, FFN, (const bf16_t*)(p.ws + OFF_WD0), FFN, ROWS, 1024, smem, e); }
  if (PH == 8) phase_norm(xres, xctx, p.norm_mix_w + 1024, mod1, 0, 1024, hm, ROWS);
  if (PH == 9) { Epi e{}; e.C = big; e.ldc = NIN1P; e.gelu_cols = 0;
    gemm_phase<0>(hm, 1024, (const bf16_t*)(p.ws + OFF_WIN1), 1024, ROWS, NIN1P, smem, e); }
  if (PH == 10) phase_mix1a(p, smem);
  if (PH == 11) phase_mix1b(p, smem);
  if (PH == 12) phase_mix1c(p, smem);
  if (PH == 13) { Epi e{}; e.src_lat = xres; e.src_ctx = xctx; e.dst = xres; e.gate = mod1 + 2048;
    gemm_phase<1>(hm, 1024, (const bf16_t*)(p.ws + OFF_WOUT1), 1024, ROWS_L, 1024, smem, e); }
  if (PH == 14) phase_norm(xres, xctx, p.norm_ffn_w + 1024, mod1, 3072, 4096, hm, ROWS_L);
  if (PH == 15) { Epi e{}; e.C = big; e.ldc = FFN;
    gemm_phase<2>(hm, 1024, (const bf16_t*)(p.ws + OFF_WGU1), 1024, ROWS_L, 2 * FFN, smem, e); }
  if (PH == 16) { Epi e{}; e.src_lat = xres; e.src_ctx = xctx; e.dst = xres; e.gate = mod1 + 5120;
    gemm_phase<1>(big, FFN, (const bf16_t*)(p.ws + OFF_WD1), FFN, ROWS_L, 1024, smem, e); }
  if (PH == 17) phase_final_norm(xres, p.final_norm_w, p.out);
}
constexpr int NPH = 18;

#ifndef MULTI_LAUNCH
#define MULTI_LAUNCH 0
#endif

#if MULTI_LAUNCH
template <int PH>
__global__ void __launch_bounds__(NT, 2) phase_kernel(Params p) {
  __shared__ __attribute__((aligned(16))) char smem[65536];
  run_phase<PH>(p, smem);
}
template <int PH>
static void launch_phases(const Params& p, int grid, hipStream_t stream) {
  phase_kernel<PH><<<dim3(grid), dim3(NT), 0, stream>>>(p);
  if constexpr (PH + 1 < NPH) launch_phases<PH + 1>(p, grid, stream);
}
#else
template <int PH>
__device__ __forceinline__ void run_all(const Params& p, char* smem, unsigned* bar, BarState& gen) {
  run_phase<PH>(p, smem);
#ifdef DOUBLE_MASK
  if constexpr ((DOUBLE_MASK >> PH) & 1) { grid_barrier(bar, gen, p.x, p.out); run_phase<PH>(p, smem); }
#endif
  if constexpr (PH + 1 < NPH) { grid_barrier(bar, gen, p.x, p.out); run_all<PH + 1>(p, smem, bar, gen); }
}
__global__ void __launch_bounds__(NT, 2) fwd_kernel(Params p) {
  __shared__ __attribute__((aligned(16))) char smem[65536];
  unsigned* bar = (unsigned*)(p.ws + OFF_BAR);
  BarState gen;
  grid_barrier_post(bar, gen);
  run_all<0>(p, smem, bar, gen);
}
#endif

extern "C" void kernel_launch(void* const* d_in, const int* in_sizes, int n_in, void* d_out, int out_size, void* d_ws, size_t ws_size,
                              hipStream_t stream) {
  if (ws_size < WS_NEED) { fprintf(stderr, "workspace too small: %zu\n", ws_size); return; }
  Params p{};
  const float** pp = (const float**)&p;
  for (int i = 0; i < 25; ++i) pp[i] = (const float*)d_in[i];
  p.out = (float*)d_out;
  p.ws = (char*)d_ws;
#if MULTI_LAUNCH
  launch_phases<0>(p, 512, stream);
#else
  static int grid_blocks = 0;
  if (!grid_blocks) {
    int dev = 0, cus = 0, per_cu = 0;
    (void)hipGetDevice(&dev);
    (void)hipDeviceGetAttribute(&cus, hipDeviceAttributeMultiprocessorCount, dev);
    (void)hipOccupancyMaxActiveBlocksPerMultiprocessor(&per_cu, fwd_kernel, NT, 0);
    if (per_cu > 2) per_cu = 2;
    if (per_cu < 1) per_cu = 1;
    grid_blocks = cus * per_cu;
  }
  (void)hipMemsetAsync((char*)d_ws + OFF_BAR, 0, 16384, stream);
  void* args[] = {&p};
  hipError_t err = hipLaunchCooperativeKernel((void*)fwd_kernel, dim3(grid_blocks), dim3(NT), args, 0, stream);
  if (err != hipSuccess) fprintf(stderr, "cooperative launch failed: %s (grid %d)\n", hipGetErrorString(err), grid_blocks);
#endif
}
```

```cpp
#include <hip/hip_runtime.h>
#include <hip/hip_cooperative_groups.h>
#include <cstdio>
namespace cg = cooperative_groups;

typedef unsigned short bf16_t;
typedef short bf16x8 __attribute__((ext_vector_type(8)));
typedef float f32x4 __attribute__((ext_vector_type(4)));

#define NT 256
constexpr int D = 1024, SEQ = 4096, NB = 8, CTXL = 256;
constexpr int ROWS_L = NB * SEQ;
constexpr int ROWS_C = NB * CTXL;
constexpr int ROWS = ROWS_L + ROWS_C;
constexpr int FFN = 2816;
constexpr int NIN0 = 2560, NIN1 = 2080, NIN1P = 2176;
constexpr int MODN = 6144;
constexpr int LDK = 72;

constexpr size_t MiB = (size_t)1 << 20;
constexpr size_t OFF_WIN0 = 0, OFF_WOUT0 = 5 * MiB, OFF_WGU0 = 7 * MiB, OFF_WD0 = 18 * MiB;
constexpr size_t OFF_WIN1 = 24 * MiB, OFF_WOUT1 = 29 * MiB, OFF_WGU1 = 31 * MiB, OFF_WD1 = 42 * MiB;
constexpr size_t OFF_MOD = 48 * MiB;
constexpr size_t OFF_TAB = 48 * MiB + 512 * 1024;
constexpr size_t OFF_BAR = 48 * MiB + 768 * 1024;
constexpr size_t OFF_XRES = 49 * MiB;
constexpr size_t OFF_HM = 185 * MiB;
constexpr size_t OFF_BIG = 253 * MiB;
constexpr size_t OFF_APR = OFF_BIG + 145 * MiB;
constexpr size_t OFF_API = OFF_BIG + 161 * MiB;
constexpr size_t OFF_EXTRA = 440 * MiB;
constexpr size_t WS_NEED = 508 * MiB;

struct Params {
  const float *x, *c, *ctx, *c_ctx, *ada_w, *ada_b, *norm_mix_w, *norm_ffn_w, *ffn_w_gate, *ffn_w_up, *ffn_w_down;
  const float *ab_w_in, *ab_w_out, *ab_sgu_norm_w, *ab_sgu_w, *ab_sgu_b, *ab_rel_bias;
  const float *cd_w_in, *cd_w_out, *cd_dw_f, *cd_db_f, *cd_dw_b, *cd_db_b, *cd_head_norm_w, *final_norm_w;
  float* out;
  char* ws;
};

__device__ __forceinline__ bf16_t f2bf(float f) {
  unsigned u = __float_as_uint(f);
  u += 0x7fffu + ((u >> 16) & 1u);
  return (bf16_t)(u >> 16);
}
__device__ __forceinline__ float bf2f(bf16_t h) { return __uint_as_float(((unsigned)h) << 16); }
__device__ __forceinline__ unsigned pack2(float a, float b) { return (unsigned)f2bf(a) | ((unsigned)f2bf(b) << 16); }
__device__ __forceinline__ float lo_bf(unsigned u) { return __uint_as_float(u << 16); }
__device__ __forceinline__ float hi_bf(unsigned u) { return __uint_as_float(u & 0xffff0000u); }
__device__ __forceinline__ float sigmoidf_(float x) { return 1.f / (1.f + __expf(-x)); }
__device__ __forceinline__ float siluf_(float x) { return x * sigmoidf_(x); }
__device__ __forceinline__ float geluf_(float x) {
  float u = 0.7978845608028654f * (x + 0.044715f * x * x * x);
  return x * sigmoidf_(2.f * u);
}
__device__ __forceinline__ float wave_sum(float v) {
#pragma unroll
  for (int o = 32; o > 0; o >>= 1) v += __shfl_xor(v, o);
  return v;
}
__device__ __forceinline__ float cos_rev(float r) { return __builtin_amdgcn_cosf(r); }
__device__ __forceinline__ float sin_rev(float r) { return __builtin_amdgcn_sinf(r); }

__device__ __forceinline__ void wt_tile(const float* __restrict__ src, const float* __restrict__ src2, int N, int ldsrc, bf16_t* __restrict__ dst,
                        int lddst, int kt, int ntile, int mode, float* tile) {
  const int tid = threadIdx.x;
#pragma unroll
  for (int i = 0; i < 4; ++i) {
    const int kk = (tid >> 4) + i * 16, j4 = (tid & 15) * 4;
    float4 v = make_float4(0.f, 0.f, 0.f, 0.f);
    if (mode == 0) {
      const int col = ntile * 64 + j4;
      if (col < N) v = *(const float4*)(src + (size_t)(kt * 64 + kk) * ldsrc + col);
    } else {
      const int col = ntile * 32 + (j4 & 31);
      const float* sp = (j4 < 32) ? src : src2;
      v = *(const float4*)(sp + (size_t)(kt * 64 + kk) * ldsrc + col);
    }
    tile[(j4 + 0) * 65 + kk] = v.x; tile[(j4 + 1) * 65 + kk] = v.y; tile[(j4 + 2) * 65 + kk] = v.z; tile[(j4 + 3) * 65 + kk] = v.w;
  }
  __syncthreads();
#pragma unroll
  for (int i = 0; i < 2; ++i) {
    const int e = tid + i * 256, j = e >> 3, k8 = (e & 7) * 8;
    const float* tp = tile + j * 65 + k8;
    uint4 pk; pk.x = pack2(tp[0], tp[1]); pk.y = pack2(tp[2], tp[3]); pk.z = pack2(tp[4], tp[5]); pk.w = pack2(tp[6], tp[7]);
    *(uint4*)(dst + (size_t)(ntile * 64 + j) * lddst + kt * 64 + k8) = pk;
  }
  __syncthreads();
}

__device__ __forceinline__ void mod_item(const Params& p, int item, float* sm) {
  const int l = item / 96, cgp = item % 96;
  const int tid = threadIdx.x, nn = tid & 63, ks = tid >> 6;
  float* sil = sm;
  float* red = sm + 4 * 9 * 256;
  for (int e = tid; e < 9 * 1024; e += NT) {
    int v = e >> 10, k = e & 1023;
    float cv = (v < 8) ? p.c[v * 1024 + k] : p.c_ctx[k];
    sil[((k >> 8) * 9 + v) * 256 + (k & 255)] = siluf_(cv);
  }
  __syncthreads();
  float acc[9];
#pragma unroll
  for (int v = 0; v < 9; ++v) acc[v] = 0.f;
  const float* w = p.ada_w + (size_t)l * 1024 * MODN + cgp * 64 + nn;
#pragma unroll 16
  for (int k = 0; k < 256; ++k) {
    float wv = w[(size_t)(ks * 256 + k) * MODN];
#pragma unroll
    for (int v = 0; v < 9; ++v) acc[v] += sil[(ks * 9 + v) * 256 + k] * wv;
  }
#pragma unroll
  for (int v = 0; v < 9; ++v) red[(ks * 9 + v) * 64 + nn] = acc[v];
  __syncthreads();
  float* mod = (float*)(p.ws + OFF_MOD);
  for (int e = tid; e < 9 * 64; e += NT) {
    int v = e >> 6, n = e & 63;
    float s = red[(0 * 9 + v) * 64 + n] + red[(1 * 9 + v) * 64 + n] + red[(2 * 9 + v) * 64 + n] + red[(3 * 9 + v) * 64 + n];
    mod[((size_t)l * 9 + v) * MODN + cgp * 64 + n] = s + p.ada_b[l * MODN + cgp * 64 + n];
  }
  __syncthreads();
}

__device__ __forceinline__ void phase_prep(const Params& p, char* smem) {
  float* sm = (float*)smem;
  bf16_t* W = (bf16_t*)p.ws;
  const int n_in0 = 16 * 40, n_out = 16 * 16, n_gu = 16 * 88, n_d = 44 * 16, n_in1 = 16 * 34;
  const int c0 = n_in0, c1 = c0 + n_out, c2 = c1 + n_gu, c3 = c2 + n_d, c4 = c3 + n_in1, c5 = c4 + n_out, c6 = c5 + n_gu, c7 = c6 + n_d;
  const int total = c7 + 192 + 1;
  for (int it = blockIdx.x; it < total; it += gridDim.x) {
    if (it < c0) { int t = it; wt_tile(p.ab_w_in, nullptr, NIN0, NIN0, (bf16_t*)(p.ws + OFF_WIN0), 1024, t / 40, t % 40, 0, sm); }
    else if (it < c1) { int t = it - c0; wt_tile(p.ab_w_out, nullptr, 1024, 1024, (bf16_t*)(p.ws + OFF_WOUT0), 1024, t / 16, t % 16, 0, sm); }
    else if (it < c2) { int t = it - c1; wt_tile(p.ffn_w_gate, p.ffn_w_up, FFN, FFN, (bf16_t*)(p.ws + OFF_WGU0), 1024, t / 88, t % 88, 1, sm); }
    else if (it < c3) { int t = it - c2; wt_tile(p.ffn_w_down, nullptr, 1024, 1024, (bf16_t*)(p.ws + OFF_WD0), FFN, t / 16, t % 16, 0, sm); }
    else if (it < c4) { int t = it - c3; wt_tile(p.cd_w_in, nullptr, NIN1, NIN1, (bf16_t*)(p.ws + OFF_WIN1), 1024, t / 34, t % 34, 0, sm); }
    else if (it < c5) { int t = it - c4; wt_tile(p.cd_w_out, nullptr, 1024, 1024, (bf16_t*)(p.ws + OFF_WOUT1), 1024, t / 16, t % 16, 0, sm); }
    else if (it < c6) { int t = it - c5; wt_tile(p.ffn_w_gate + (size_t)1024 * FFN, p.ffn_w_up + (size_t)1024 * FFN, FFN, FFN, (bf16_t*)(p.ws + OFF_WGU1), 1024, t / 88, t % 88, 1, sm); }
    else if (it < c7) { int t = it - c6; wt_tile(p.ffn_w_down + (size_t)FFN * 1024, nullptr, 1024, 1024, (bf16_t*)(p.ws + OFF_WD1), FFN, t / 16, t % 16, 0, sm); }
    else if (it < c7 + 192) { mod_item(p, it - c7, sm); }
    else {
      float* tab = (float*)(p.ws + OFF_TAB);
      for (int e = threadIdx.x; e < 128; e += NT) { tab[e] = cos_rev(e / 128.f); tab[128 + e] = sin_rev(e / 128.f); }
      for (int e = threadIdx.x; e < 64; e += NT) { tab[256 + e] = cos_rev(e / 64.f); tab[320 + e] = sin_rev(e / 64.f); }
      for (int e = threadIdx.x; e < 4096; e += NT) { tab[384 + e] = cos_rev(e / 4096.f); tab[4480 + e] = sin_rev(e / 4096.f); }
      for (int e = threadIdx.x; e < 1024; e += NT) {
        int pos = e >> 4, i = e & 15;
        float inv = __expf(-(float)i / 16.f * 9.210340371976184f);
        float ang = (float)pos * inv;
        float rev = ang * 0.15915494309189535f;
        rev = rev - floorf(rev);
        tab[8576 + e] = cos_rev(rev); tab[9600 + e] = sin_rev(rev);
      }
      bf16_t* t1 = (bf16_t*)(p.ws + OFF_TAB + 65536);
      for (int e = threadIdx.x; e < 32768; e += NT) {
        const int n = e >> 7, cidx = e & 127;
        const float rev = (float)((cidx * (n & 127)) & 127) / 128.f;
        t1[e] = f2bf(n < 128 ? cos_rev(rev) : -sin_rev(rev));
      }
      bf16_t* c64 = t1 + 32768;
      for (int e = threadIdx.x; e < 4096; e += NT) {
        const float rev = (float)(((e >> 6) * (e & 63)) & 63) / 64.f;
        const float cv = cos_rev(rev), sv = sin_rev(rev);
        c64[e] = f2bf(cv); c64[4096 + e] = f2bf(sv); c64[8192 + e] = f2bf(-sv);
      }
    }
  }
}

__device__ __forceinline__ void phase_norm(const float* __restrict__ src_lat, const float* __restrict__ src_ctx, const float* __restrict__ w,
                           const float* __restrict__ modl  , int sh_off, int sc_off, bf16_t* __restrict__ dst, int nrows) {
  const int lane = threadIdx.x & 63, wid = threadIdx.x >> 6;
  for (int r = blockIdx.x * 4 + wid; r < nrows; r += gridDim.x * 4) {
    const float* s = (r < ROWS_L) ? src_lat + (size_t)r * 1024 : src_ctx + (size_t)(r - ROWS_L) * 1024;
    const int vec = (r < ROWS_L) ? (r >> 12) : 8;
    const float* mv = modl + (size_t)vec * MODN;
    float4 v[4];
    float ss = 0.f;
#pragma unroll
    for (int i = 0; i < 4; ++i) {
      v[i] = *(const float4*)(s + i * 256 + lane * 4);
      ss += v[i].x * v[i].x + v[i].y * v[i].y + v[i].z * v[i].z + v[i].w * v[i].w;
    }
    ss = wave_sum(ss);
    const float rstd = rsqrtf(ss * (1.f / 1024.f) + 1e-6f);
#pragma unroll
    for (int i = 0; i < 4; ++i) {
      const int cidx = i * 256 + lane * 4;
      float4 wv = *(const float4*)(w + cidx);
      float4 sc = *(const float4*)(mv + sc_off + cidx);
      float4 sh = *(const float4*)(mv + sh_off + cidx);
      float o0 = v[i].x * rstd * wv.x * (1.f + sc.x) + sh.x;
      float o1 = v[i].y * rstd * wv.y * (1.f + sc.y) + sh.y;
      float o2 = v[i].z * rstd * wv.z * (1.f + sc.z) + sh.z;
      float o3 = v[i].w * rstd * wv.w * (1.f + sc.w) + sh.w;
      uint2 pk; pk.x = pack2(o0, o1); pk.y = pack2(o2, o3);
      *(uint2*)(dst + (size_t)r * 1024 + cidx) = pk;
    }
  }
}

__device__ __forceinline__ void phase_final_norm(const float* __restrict__ src, const float* __restrict__ w, float* __restrict__ dst) {
  const int lane = threadIdx.x & 63, wid = threadIdx.x >> 6;
  for (int r = blockIdx.x * 4 + wid; r < ROWS_L; r += gridDim.x * 4) {
    const float* s = src + (size_t)r * 1024;
    float4 v[4];
    float ss = 0.f;
#pragma unroll
    for (int i = 0; i < 4; ++i) {
      v[i] = *(const float4*)(s + i * 256 + lane * 4);
      ss += v[i].x * v[i].x + v[i].y * v[i].y + v[i].z * v[i].z + v[i].w * v[i].w;
    }
    ss = wave_sum(ss);
    const float rstd = rsqrtf(ss * (1.f / 1024.f) + 1e-6f);
#pragma unroll
    for (int i = 0; i < 4; ++i) {
      const int cidx = i * 256 + lane * 4;
      float4 wv = *(const float4*)(w + cidx);
      float4 o; o.x = v[i].x * rstd * wv.x; o.y = v[i].y * rstd * wv.y; o.z = v[i].z * rstd * wv.z; o.w = v[i].w * rstd * wv.w;
      *(float4*)(dst + (size_t)r * 1024 + cidx) = o;
    }
  }
}

struct Epi {
  bf16_t* C; int ldc; int gelu_cols;
  const float* src_lat; const float* src_ctx;
  float* dst;
  const float* gate;
};

template <int EPI>
__device__ __forceinline__ void gemm_phase(const bf16_t* __restrict__ A, int lda, const bf16_t* __restrict__ Bt, int K, int Mrows, int N,
                           char* smem, const Epi ep) {
  constexpr int IM = 8;
  const int tid = threadIdx.x, lane = tid & 63, wid = tid >> 6, wm = wid >> 1, wn = wid & 1;
  const int fr = lane & 15, fq = lane >> 4;
  const int nMt = Mrows / 256, nNt = N / 128, ntiles = nMt * nNt, nk = K / 64;
  const int drow = lane >> 3, dkc = (lane & 7) ^ (lane >> 3);
  const int ko0 = ((fq) ^ (fr & 7)) * 16, ko1 = ((4 + fq) ^ (fr & 7)) * 16;
  const int vb = (int)(blockIdx.x & 7u) * (int)(gridDim.x >> 3) + (int)(blockIdx.x >> 3);
  for (int tile = vb; tile < ntiles; tile += gridDim.x) {
    const int grp = tile / (8 * nNt), wi = tile % (8 * nNt);
    const int mt = grp * 8 + (wi & 7), nt = wi >> 3;
    const int m0 = mt * 256, n0 = nt * 128;
    f32x4 acc[IM][4];
#pragma unroll
    for (int i = 0; i < IM; ++i)
#pragma unroll
      for (int j = 0; j < 4; ++j) acc[i][j] = (f32x4){0.f, 0.f, 0.f, 0.f};
    const bf16_t* gA = A + (size_t)(m0 + wid * 64 + drow) * lda + dkc * 8;
    const bf16_t* gB = Bt + (size_t)(n0 + wid * 32 + drow) * K + dkc * 8;
    auto dma_tile = [&](int kt_) {
      char* sb_ = smem + lane * 16;
#pragma unroll
      for (int i = 0; i < 8; ++i)
        __builtin_amdgcn_global_load_lds((const unsigned*)(gA + (size_t)i * 8 * lda + kt_ * 64), (unsigned*)(sb_ + (wid * 8 + i) * 1024), 16, 0, 0);
#pragma unroll
      for (int i = 0; i < 4; ++i)
        __builtin_amdgcn_global_load_lds((const unsigned*)(gB + (size_t)i * 8 * K + kt_ * 64), (unsigned*)(sb_ + 32768 + (wid * 4 + i) * 1024), 16, 0, 0);
    };
    const char* as = smem + (wm * 128 + fr) * 128;
    const char* bs = smem + 32768 + (wn * 64 + fr) * 128;
    asm volatile("s_waitcnt vmcnt(0)" ::: "memory");
    __syncthreads();
    dma_tile(0);
    for (int kt = 0; kt < nk; ++kt) {
      asm volatile("s_waitcnt vmcnt(0)" ::: "memory");
      __builtin_amdgcn_s_barrier();
      asm volatile("" ::: "memory");
      bf16x8 af[IM], bfr[4];
#pragma unroll
      for (int j = 0; j < 4; ++j) bfr[j] = *(const bf16x8*)(bs + j * 2048 + ko0);
#pragma unroll
      for (int i = 0; i < IM; ++i) af[i] = *(const bf16x8*)(as + i * 2048 + ko0);
      __builtin_amdgcn_sched_barrier(0);
#pragma unroll
      for (int i = 0; i < IM; ++i)
#pragma unroll
        for (int j = 0; j < 4; ++j) acc[i][j] = __builtin_amdgcn_mfma_f32_16x16x32_bf16(bfr[j], af[i], acc[i][j], 0, 0, 0);
      __builtin_amdgcn_sched_barrier(0);
#pragma unroll
      for (int j = 0; j < 4; ++j) bfr[j] = *(const bf16x8*)(bs + j * 2048 + ko1);
#pragma unroll
      for (int i = 0; i < IM; ++i) af[i] = *(const bf16x8*)(as + i * 2048 + ko1);
      __builtin_amdgcn_sched_barrier(0);
      asm volatile("s_waitcnt lgkmcnt(0)" ::: "memory");
      __builtin_amdgcn_s_barrier();
      asm volatile("" ::: "memory");
      if (kt + 1 < nk) dma_tile(kt + 1);
      __builtin_amdgcn_sched_barrier(0);
#pragma unroll
      for (int i = 0; i < IM; ++i)
#pragma unroll
        for (int j = 0; j < 4; ++j) acc[i][j] = __builtin_amdgcn_mfma_f32_16x16x32_bf16(bfr[j], af[i], acc[i][j], 0, 0, 0);
      __builtin_amdgcn_sched_barrier(0);
    }
    if (EPI == 0) {
      const bool do_gelu = n0 < ep.gelu_cols;
#pragma unroll
      for (int i = 0; i < IM; ++i) {
        const int m = m0 + wm * 128 + i * 16 + fr;
#pragma unroll
        for (int j = 0; j < 4; ++j) {
          const int n = n0 + wn * 64 + j * 16 + fq * 4;
          f32x4 v = acc[i][j];
          if (do_gelu) { v[0] = geluf_(v[0]); v[1] = geluf_(v[1]); v[2] = geluf_(v[2]); v[3] = geluf_(v[3]); }
          uint2 pk; pk.x = pack2(v[0], v[1]); pk.y = pack2(v[2], v[3]);
          *(uint2*)(ep.C + (size_t)m * ep.ldc + n) = pk;
        }
      }
    } else if (EPI == 1) {
      const int vec = (m0 < ROWS_L) ? (m0 >> 12) : 8;
      const float* gv = ep.gate + (size_t)vec * MODN;
#pragma unroll
      for (int i = 0; i < IM; ++i) {
        const int m = m0 + wm * 128 + i * 16 + fr;
        const float* srow_p = (m < ROWS_L) ? ep.src_lat + (size_t)m * 1024 : ep.src_ctx + (size_t)(m - ROWS_L) * 1024;
#pragma unroll
        for (int j = 0; j < 4; ++j) {
          const int n = n0 + wn * 64 + j * 16 + fq * 4;
          float4 sv = *(const float4*)(srow_p + n);
          float4 g = *(const float4*)(gv + n);
          float4 o;
          o.x = sv.x + g.x * acc[i][j][0]; o.y = sv.y + g.y * acc[i][j][1];
          o.z = sv.z + g.z * acc[i][j][2]; o.w = sv.w + g.w * acc[i][j][3];
          *(float4*)(ep.dst + (size_t)m * 1024 + n) = o;
        }
      }
    } else {
#pragma unroll
      for (int i = 0; i < IM; ++i) {
        const int m = m0 + wm * 128 + i * 16 + fr;
#pragma unroll
        for (int j = 0; j < 2; ++j) {
          const int n = (n0 >> 1) + wn * 32 + j * 16 + fq * 4;
          f32x4 g = acc[i][j], u = acc[i][j + 2];
          uint2 pk;
          pk.x = pack2(siluf_(g[0]) * u[0], siluf_(g[1]) * u[1]);
          pk.y = pack2(siluf_(g[2]) * u[2], siluf_(g[3]) * u[3]);
          *(uint2*)(ep.C + (size_t)m * ep.ldc + n) = pk;
        }
      }
    }
  }
}

__device__ __forceinline__ void sgu_item(const Params& p, int ck, int g, const bf16_t* __restrict__ pb, bf16_t* __restrict__ mix, char* smem) {
  constexpr int LDV = 136;
  bf16_t* vnT = (bf16_t*)smem;
  int tid = threadIdx.x;
  asm volatile("" : "+v"(tid));
  const int r0 = ck * 128;
  {
    const int q = tid >> 1, half = tid & 1;
    const bf16_t* vrow = pb + (size_t)(r0 + q) * NIN0 + 512 + half * 256;
    float ss = 0.f;
#pragma unroll 4
    for (int i = 0; i < 32; ++i) {
      uint4 u = *(const uint4*)(vrow + i * 8);
      float a;
      a = lo_bf(u.x); ss += a * a; a = hi_bf(u.x); ss += a * a;
      a = lo_bf(u.y); ss += a * a; a = hi_bf(u.y); ss += a * a;
      a = lo_bf(u.z); ss += a * a; a = hi_bf(u.z); ss += a * a;
      a = lo_bf(u.w); ss += a * a; a = hi_bf(u.w); ss += a * a;
    }
    ss += __shfl_xor(ss, 1);
    const float rstd = rsqrtf(ss * (1.f / 512.f) + 1e-6f);
    const bf16_t* vg = pb + (size_t)(r0 + q) * NIN0 + 512 + g * 128 + half * 64;
    const float* nw = p.ab_sgu_norm_w + g * 128 + half * 64;
#pragma unroll 2
    for (int i = 0; i < 8; ++i) {
      const uint4 u = *(const uint4*)(vg + i * 8);
      const float4 w0 = *(const float4*)(nw + i * 8), w1 = *(const float4*)(nw + i * 8 + 4);
      bf16_t* dp = vnT + (half * 64 + i * 8) * LDV + q;
      dp[0 * LDV] = f2bf(lo_bf(u.x) * rstd * w0.x); dp[1 * LDV] = f2bf(hi_bf(u.x) * rstd * w0.y);
      dp[2 * LDV] = f2bf(lo_bf(u.y) * rstd * w0.z); dp[3 * LDV] = f2bf(hi_bf(u.y) * rstd * w0.w);
      dp[4 * LDV] = f2bf(lo_bf(u.z) * rstd * w1.x); dp[5 * LDV] = f2bf(hi_bf(u.z) * rstd * w1.y);
      dp[6 * LDV] = f2bf(lo_bf(u.w) * rstd * w1.z); dp[7 * LDV] = f2bf(hi_bf(u.w) * rstd * w1.w);
    }
  }
  __syncthreads();
  {
    const int lane = tid & 63, wv = tid >> 6, fr = lane & 15, fq = lane >> 4;
    const float* W = p.ab_sgu_w + (size_t)g * 128 * 128;
    f32x4 acc[2][8];
#pragma unroll
    for (int i = 0; i < 2; ++i)
#pragma unroll
      for (int j = 0; j < 8; ++j) acc[i][j] = (f32x4){0.f, 0.f, 0.f, 0.f};
#pragma unroll
    for (int s4 = 0; s4 < 4; ++s4) {
      bf16x8 af[2];
#pragma unroll
      for (int i = 0; i < 2; ++i) {
        const float* wp = W + (wv * 32 + i * 16 + fr) * 128 + s4 * 32 + fq * 8;
        const float4 a0 = *(const float4*)wp, a1 = *(const float4*)(wp + 4);
        uint4 pk; pk.x = pack2(a0.x, a0.y); pk.y = pack2(a0.z, a0.w); pk.z = pack2(a1.x, a1.y); pk.w = pack2(a1.z, a1.w);
        af[i] = *(bf16x8*)&pk;
      }
#pragma unroll
      for (int j = 0; j < 8; ++j) {
        const bf16x8 bfr = *(const bf16x8*)(vnT + (j * 16 + fr) * LDV + s4 * 32 + fq * 8);
        acc[0][j] = __builtin_amdgcn_mfma_f32_16x16x32_bf16(bfr, af[0], acc[0][j], 0, 0, 0);
        acc[1][j] = __builtin_amdgcn_mfma_f32_16x16x32_bf16(bfr, af[1], acc[1][j], 0, 0, 0);
      }
    }
#pragma unroll
    for (int i = 0; i < 2; ++i) {
      const int pp = wv * 32 + i * 16 + fr;
      const float bias = p.ab_sgu_b[g * 128 + pp];
#pragma unroll
      for (int j = 0; j < 8; ++j) {
        const int cc = j * 16 + fq * 4;
        const uint2 uu = *(const uint2*)(pb + (size_t)(r0 + pp) * NIN0 + g * 128 + cc);
        uint2 pk;
        pk.x = pack2(lo_bf(uu.x) * (acc[i][j][0] + bias), hi_bf(uu.x) * (acc[i][j][1] + bias));
        pk.y = pack2(lo_bf(uu.y) * (acc[i][j][2] + bias), hi_bf(uu.y) * (acc[i][j][3] + bias));
        *(uint2*)(mix + (size_t)(r0 + pp) * 1024 + g * 128 + cc) = pk;
      }
    }
  }
  __syncthreads();
}

__device__ __forceinline__ void attn_item(const Params& p, bool latent, int b, int rq, int h, const bf16_t* __restrict__ pb, bf16_t* __restrict__ mix, char* smem) {
  int tid = threadIdx.x;
  asm volatile("" : "+v"(tid));
  const int lane = tid & 63, wv = tid >> 6, fr = lane & 15, fq = lane >> 4;
  const int qcol = wv * 16 + fr;
  const int qrow = latent ? (b * 4096 + rq * 64 + qcol) : (ROWS_L + b * 256 + rq * 64 + qcol);
  const int nnb = latent ? 8 : 0, nblk = nnb + 4;
  const int row_start = min(max(rq - 4, 0), 56);
  const int col_start = min(max(qcol - 8, 0), 48);
  const int kc0 = min(max(wv * 16 - 8, 0), 32);
  bf16x8 qf[2];
#pragma unroll
  for (int s2 = 0; s2 < 2; ++s2) {
    const uint4 u = *(const uint4*)(pb + (size_t)qrow * NIN0 + 1024 + h * 64 + s2 * 32 + fq * 8);
    uint4 v;
    v.x = pack2(lo_bf(u.x) * 0.125f, hi_bf(u.x) * 0.125f); v.y = pack2(lo_bf(u.y) * 0.125f, hi_bf(u.y) * 0.125f);
    v.z = pack2(lo_bf(u.z) * 0.125f, hi_bf(u.z) * 0.125f); v.w = pack2(lo_bf(u.w) * 0.125f, hi_bf(u.w) * 0.125f);
    qf[s2] = *(bf16x8*)&v;
  }
  f32x4 o[4];
#pragma unroll
  for (int dt = 0; dt < 4; ++dt) o[dt] = (f32x4){0.f, 0.f, 0.f, 0.f};
  float mrow = -1e30f, lsum = 0.f;
  uint4 rk[2], rv[2];
  auto blk_row = [&](int kb) -> int { return (kb < nnb) ? (b * 4096 + (row_start + kb) * 64) : (ROWS_L + b * 256 + (kb - nnb) * 64); };
  auto gload = [&](int kb) {
    const int r0 = blk_row(kb);
#pragma unroll
    for (int i = 0; i < 2; ++i) {
      const int sidx = tid + i * 256, key = sidx & 63, c8 = sidx >> 6;
      const bf16_t* rp = pb + (size_t)(r0 + key) * NIN0 + h * 64 + c8 * 8;
      rk[i] = *(const uint4*)(rp + 1536);
      rv[i] = *(const uint4*)(rp + 2048);
    }
  };
  auto lstore = [&](int buf) {
    bf16_t* kb_ = (bf16_t*)(smem + buf * 18432);
    bf16_t* vt_ = (bf16_t*)(smem + buf * 18432 + 9216);
#pragma unroll
    for (int i = 0; i < 2; ++i) {
      const int sidx = tid + i * 256, key = sidx & 63, c8 = sidx >> 6;
      *(uint4*)(kb_ + key * LDK + c8 * 8) = rk[i];
      bf16_t* dp = vt_ + (c8 * 8) * LDK + key;
      const uint4 u = rv[i];
      dp[0 * LDK] = (bf16_t)(u.x & 0xffff); dp[1 * LDK] = (bf16_t)(u.x >> 16);
      dp[2 * LDK] = (bf16_t)(u.y & 0xffff); dp[3 * LDK] = (bf16_t)(u.y >> 16);
      dp[4 * LDK] = (bf16_t)(u.z & 0xffff); dp[5 * LDK] = (bf16_t)(u.z >> 16);
      dp[6 * LDK] = (bf16_t)(u.w & 0xffff); dp[7 * LDK] = (bf16_t)(u.w >> 16);
    }
  };
  gload(0);
  lstore(0);
  __syncthreads();
  for (int kb = 0; kb < nblk; ++kb) {
    const int buf = kb & 1;
    if (kb + 1 < nblk) gload(kb + 1);
    const bf16_t* kbuf = (const bf16_t*)(smem + buf * 18432);
    const bf16_t* vtb = (const bf16_t*)(smem + buf * 18432 + 9216);
    const bool nb = kb < nnb;
    const int k0 = nb ? kc0 : 0;
    const int ntile = nb ? 2 : 4;
    f32x4 sc[4];
#pragma unroll
    for (int j = 0; j < 4; ++j) sc[j] = (f32x4){0.f, 0.f, 0.f, 0.f};
#pragma unroll
    for (int j = 0; j < 4; ++j) {
      if (j < ntile) {
#pragma unroll
        for (int s2 = 0; s2 < 2; ++s2) {
          const bf16x8 kf = *(const bf16x8*)(kbuf + (k0 + j * 16 + fr) * LDK + s2 * 32 + fq * 8);
          sc[j] = __builtin_amdgcn_mfma_f32_16x16x32_bf16(kf, qf[s2], sc[j], 0, 0, 0);
        }
      }
    }
    float bm = -1e30f;
    if (nb) {
      const int dr = row_start + kb - rq + 7;
      const float* bp = p.ab_rel_bias + (h * 15 + dr) * 31 + 15 - qcol;
#pragma unroll
      for (int j = 0; j < 2; ++j)
#pragma unroll
        for (int r = 0; r < 4; ++r) {
          const int kc = k0 + j * 16 + fq * 4 + r;
          const bool ok = (kc >= col_start) && (kc < col_start + 16);
          const float v = ok ? sc[j][r] + bp[ok ? kc : qcol] : -1e30f;
          sc[j][r] = v;
          bm = fmaxf(bm, v);
        }
    } else {
#pragma unroll
      for (int j = 0; j < 4; ++j)
#pragma unroll
        for (int r = 0; r < 4; ++r) bm = fmaxf(bm, sc[j][r]);
    }
    bm = fmaxf(bm, __shfl_xor(bm, 16));
    bm = fmaxf(bm, __shfl_xor(bm, 32));
    const float mnew = fmaxf(mrow, bm);
    const float corr = __expf(mrow - mnew);
    mrow = mnew;
    float ps = 0.f;
#pragma unroll
    for (int j = 0; j < 4; ++j)
#pragma unroll
      for (int r = 0; r < 4; ++r) {
        const float pe = (j < ntile) ? __expf(sc[j][r] - mnew) : 0.f;
        sc[j][r] = pe;
        ps += pe;
      }
    lsum = lsum * corr + ps;
#pragma unroll
    for (int dt = 0; dt < 4; ++dt) { o[dt][0] *= corr; o[dt][1] *= corr; o[dt][2] *= corr; o[dt][3] *= corr; }
#pragma unroll
    for (int jp = 0; jp < 2; ++jp) {
      if (jp * 2 < ntile) {
        uint4 pk;
        pk.x = pack2(sc[2 * jp][0], sc[2 * jp][1]); pk.y = pack2(sc[2 * jp][2], sc[2 * jp][3]);
        pk.z = pack2(sc[2 * jp + 1][0], sc[2 * jp + 1][1]); pk.w = pack2(sc[2 * jp + 1][2], sc[2 * jp + 1][3]);
        const bf16x8 pf = *(bf16x8*)&pk;
#pragma unroll
        for (int dt = 0; dt < 4; ++dt) {
          const bf16_t* vp = vtb + (dt * 16 + fr) * LDK + k0 + jp * 32 + fq * 4;
          uint4 vv;
          const uint2 lo = *(const uint2*)vp, hi = *(const uint2*)(vp + 16);
          vv.x = lo.x; vv.y = lo.y; vv.z = hi.x; vv.w = hi.y;
          o[dt] = __builtin_amdgcn_mfma_f32_16x16x32_bf16(*(bf16x8*)&vv, pf, o[dt], 0, 0, 0);
        }
      }
    }
    if (kb + 1 < nblk) lstore(buf ^ 1);
    __syncthreads();
  }
  lsum += __shfl_xor(lsum, 16);
  lsum += __shfl_xor(lsum, 32);
  const float inv = 1.f / lsum;
#pragma unroll
  for (int dt = 0; dt < 4; ++dt) {
    uint2 pk; pk.x = pack2(o[dt][0] * inv, o[dt][1] * inv); pk.y = pack2(o[dt][2] * inv, o[dt][3] * inv);
    *(uint2*)(mix + (size_t)qrow * 1024 + 512 + h * 64 + dt * 16 + fq * 4) = pk;
  }
}

__device__ __forceinline__ void phase_mix0(const Params& p, char* smem) {
  const bf16_t* pb = (const bf16_t*)(p.ws + OFF_BIG);
  bf16_t* mix = (bf16_t*)(p.ws + OFF_HM);
  const int n_sgu = 272 * 4, n_al = 8 * 64 * 8, n_ac = 8 * 4 * 8;
  const int total = n_sgu + n_al + n_ac;
  for (int it = blockIdx.x; it < total; it += gridDim.x) {
    if (it < n_al) { int t = it; attn_item(p, true, t >> 9, (t >> 3) & 63, t & 7, pb, mix, smem); }
    else if (it < n_al + n_ac) { int t = it - n_al; attn_item(p, false, t >> 5, (t >> 3) & 3, t & 7, pb, mix, smem); }
    else { int t = it - n_al - n_ac; sgu_item(p, t >> 2, t & 3, pb, mix, smem); }
  }
}


constexpr size_t OFF_DEC = OFF_BIG + 177 * MiB;
template <int NJ>
__device__ __forceinline__ void wave_mma_lds(const bf16_t* A, const bf16_t* Bt, f32x4 (&acc)[NJ], int fr, int fq) {
#pragma unroll
  for (int s = 0; s < 2; ++s) {
    const bf16x8 a = *(const bf16x8*)(A + fr * LDK + s * 32 + fq * 8);
#pragma unroll
    for (int j = 0; j < NJ; ++j) {
      const bf16x8 b = *(const bf16x8*)(Bt + (j * 16 + fr) * LDK + s * 32 + fq * 8);
      acc[j] = __builtin_amdgcn_mfma_f32_16x16x32_bf16(b, a, acc[j], 0, 0, 0);
    }
  }
}
template <int NJ>
__device__ __forceinline__ void wave_mma_glb(const bf16_t* A, const bf16_t* Btg, f32x4 (&acc)[NJ], int fr, int fq) {
#pragma unroll
  for (int s = 0; s < 2; ++s) {
    const bf16x8 a = *(const bf16x8*)(A + fr * LDK + s * 32 + fq * 8);
#pragma unroll
    for (int j = 0; j < NJ; ++j) {
      const bf16x8 b = *(const bf16x8*)(Btg + (j * 16 + fr) * 64 + s * 32 + fq * 8);
      acc[j] = __builtin_amdgcn_mfma_f32_16x16x32_bf16(b, a, acc[j], 0, 0, 0);
    }
  }
}

template <bool LATENT, bool WANT_OUT, bool WANT_KV>
__device__ __forceinline__ void gla_prep(const Params& p, const bf16_t* __restrict__ pb, int rbase, int h, int dir, int n, char* smem, float* decay_out) {
  bf16_t* kraw = (bf16_t*)smem;
  bf16_t* qraw = (bf16_t*)(smem + 8192);
  float* tot = (float*)(smem + 16384);
  bf16_t* qe = (bf16_t*)(smem + 17408);
  bf16_t* kinv = (bf16_t*)(smem + 26624);
  bf16_t* kdecT = (bf16_t*)(smem + 35840);
  const float* tab = (const float*)(p.ws + OFF_TAB);
  int tid = threadIdx.x;
  asm volatile("" : "+v"(tid));
  const int d = tid & 63, lq = tid >> 6;
#pragma unroll
  for (int i = 0; i < 2; ++i) {
    const int idx = tid + i * 256, l = idx >> 3, c8 = idx & 7;
    const bf16_t* rp = pb + (size_t)(rbase + l) * NIN1P + h * 64 + c8 * 8;
    *(uint4*)(kraw + l * 64 + c8 * 8) = *(const uint4*)(rp + 768);
    if (WANT_OUT) *(uint4*)(qraw + l * 64 + c8 * 8) = *(const uint4*)(rp + 512);
  }
  bf16_t* araw = (bf16_t*)(smem + 63488);
  if (tid < 128) {
    const int l = tid >> 1, hf = tid & 1;
    *(uint4*)(araw + l * 16 + hf * 8) = *(const uint4*)(pb + (size_t)(rbase + l) * NIN1P + 2048 + dir * 16 + hf * 8);
  }
  const float* dw = dir ? p.cd_dw_b : p.cd_dw_f;
  const float* db = dir ? p.cd_db_b : p.cd_db_f;
  float w[16];
#pragma unroll
  for (int j = 0; j < 16; ++j) w[j] = dw[j * 256 + h * 64 + d];
  const float bias = db[h * 64 + d];
  float c[16];
  __syncthreads();
#pragma unroll
  for (int i = 0; i < 16; ++i) {
    const bf16_t* ap = araw + (lq * 16 + i) * 16;
    const uint4 u0 = *(const uint4*)ap, u1 = *(const uint4*)(ap + 8);
    float x = bias;
    x += lo_bf(u0.x) * w[0] + hi_bf(u0.x) * w[1] + lo_bf(u0.y) * w[2] + hi_bf(u0.y) * w[3];
    x += lo_bf(u0.z) * w[4] + hi_bf(u0.z) * w[5] + lo_bf(u0.w) * w[6] + hi_bf(u0.w) * w[7];
    x += lo_bf(u1.x) * w[8] + hi_bf(u1.x) * w[9] + lo_bf(u1.y) * w[10] + hi_bf(u1.y) * w[11];
    x += lo_bf(u1.z) * w[12] + hi_bf(u1.z) * w[13] + lo_bf(u1.w) * w[14] + hi_bf(u1.w) * w[15];
    c[i] = (fminf(x, 0.f) - __logf(1.f + __expf(-fabsf(x)))) * (1.f / 16.f);
    __builtin_amdgcn_sched_barrier(0);
  }
  if (dir == 0) {
#pragma unroll
    for (int i = 1; i < 16; ++i) c[i] += c[i - 1];
    tot[lq * 64 + d] = c[15];
  } else {
#pragma unroll
    for (int i = 14; i >= 0; --i) c[i] += c[i + 1];
    tot[lq * 64 + d] = c[0];
  }
  __syncthreads();
  const float t0 = tot[d], t1 = tot[64 + d], t2 = tot[128 + d], t3 = tot[192 + d];
  const float ctot = (t0 + t1) + (t2 + t3);
  float off;
  if (dir == 0) off = (lq > 0 ? t0 : 0.f) + (lq > 1 ? t1 : 0.f) + (lq > 2 ? t2 : 0.f);
  else off = (lq < 3 ? t3 : 0.f) + (lq < 2 ? t2 : 0.f) + (lq < 1 ? t1 : 0.f);
  float kd_prev = 0.f;
#pragma unroll
  for (int i = 0; i < 16; ++i) {
    const int l = lq * 16 + i;
    const float cc = c[i] + off;
    float kv = bf2f(kraw[l * 64 + d]);
    float qv = WANT_OUT ? bf2f(qraw[l * 64 + d]) : 0.f;
    if (LATENT) {
      const float kp = bf2f(kraw[l * 64 + (d ^ 16)]);
      const int pos = (d < 32) ? n : l;
      const float cs = tab[8576 + pos * 16 + (d & 15)], sn = tab[9600 + pos * 16 + (d & 15)];
      const float sg = (d & 16) ? sn : -sn;
      kv = kv * cs + kp * sg;
      if (WANT_OUT) { const float qp = bf2f(qraw[l * 64 + (d ^ 16)]); qv = qv * cs + qp * sg; }
    }
    if (WANT_OUT) {
      qe[l * LDK + d] = f2bf(qv * 0.125f * __expf(cc));
      kinv[l * LDK + d] = f2bf(kv * __expf(-cc));
    }
    if (WANT_KV) {
      const float kd = kv * __expf(ctot - cc);
      if (i & 1) *(unsigned*)(kdecT + d * LDK + l - 1) = pack2(kd_prev, kd);
      kd_prev = kd;
    }
    __builtin_amdgcn_sched_barrier(0);
  }
  if (WANT_KV && lq == 0) decay_out[d] = __expf(ctot);
}

__device__ __forceinline__ void gla_stage_vT(const bf16_t* __restrict__ pb, int rbase, int h, char* smem) {
  bf16_t* vT = (bf16_t*)(smem + 45056);
  const int tid = threadIdx.x;
#pragma unroll
  for (int i = 0; i < 4; ++i) {
    const int idx = tid + i * 256, l = idx & 63, e8 = idx >> 6;
    const uint4 u = *(const uint4*)(pb + (size_t)(rbase + l) * NIN1P + 1024 + h * 128 + e8 * 8);
    bf16_t* dp = vT + (e8 * 8) * LDK + l;
    dp[0 * LDK] = (bf16_t)(u.x & 0xffff); dp[1 * LDK] = (bf16_t)(u.x >> 16);
    dp[2 * LDK] = (bf16_t)(u.y & 0xffff); dp[3 * LDK] = (bf16_t)(u.y >> 16);
    dp[4 * LDK] = (bf16_t)(u.z & 0xffff); dp[5 * LDK] = (bf16_t)(u.z >> 16);
    dp[6 * LDK] = (bf16_t)(u.w & 0xffff); dp[7 * LDK] = (bf16_t)(u.w >> 16);
  }
}

__device__ __forceinline__ void gla_kv_item(const Params& p, int b, int h, int dir, int j, const bf16_t* __restrict__ pb, char* smem) {
  const int sidx = ((b * 4 + h) * 2 + dir) * 68 + j;
  bf16_t* slot = (bf16_t*)(p.ws + OFF_EXTRA) + (size_t)sidx * 8192;
  float* dec = (float*)(p.ws + OFF_DEC) + (size_t)sidx * 64;
  int rbase;
  if (j < 4) {
    const int nc = dir ? 3 - j : j;
    rbase = ROWS_L + b * 256 + nc * 64;
    gla_prep<false, false, true>(p, pb, rbase, h, dir, 0, smem, dec);
  } else {
    const int jj = j - 4, n = dir ? 63 - jj : jj;
    rbase = b * 4096 + n * 64;
    gla_prep<true, false, true>(p, pb, rbase, h, dir, n, smem, dec);
  }
  gla_stage_vT(pb, rbase, h, smem);
  __syncthreads();
  const bf16_t* kdecT = (const bf16_t*)(smem + 35840);
  const bf16_t* vT = (const bf16_t*)(smem + 45056);
  const int lane = threadIdx.x & 63, wv = threadIdx.x >> 6, fr = lane & 15, fq = lane >> 4;
#pragma unroll
  for (int i2 = 0; i2 < 2; ++i2) {
    f32x4 acc[4];
#pragma unroll
    for (int jn = 0; jn < 4; ++jn) acc[jn] = (f32x4){0.f, 0.f, 0.f, 0.f};
    wave_mma_lds<4>(vT + (wv * 32 + i2 * 16) * LDK, kdecT, acc, fr, fq);
    const int e = wv * 32 + i2 * 16 + fr;
#pragma unroll
    for (int jn = 0; jn < 4; ++jn) {
      uint2 pk; pk.x = pack2(acc[jn][0], acc[jn][1]); pk.y = pack2(acc[jn][2], acc[jn][3]);
      *(uint2*)(slot + e * 64 + jn * 16 + fq * 4) = pk;
    }
  }
  __syncthreads();
}

__device__ __forceinline__ void gla_scan_item(const Params& p, int bhd, int es) {
  const int tid = threadIdx.x, e = es * 32 + (tid >> 3), d0 = (tid & 7) * 8;
  bf16_t* base = (bf16_t*)(p.ws + OFF_EXTRA) + (size_t)bhd * 68 * 8192 + e * 64 + d0;
  const float* dec = (const float*)(p.ws + OFF_DEC) + (size_t)bhd * 68 * 64 + d0;
  float s[8];
#pragma unroll
  for (int k = 0; k < 8; ++k) s[k] = 0.f;
#pragma unroll 4
  for (int j = 0; j < 68; ++j) {
    const uint4 u = *(const uint4*)(base + (size_t)j * 8192);
    const float4 da = *(const float4*)(dec + j * 64), dbb = *(const float4*)(dec + j * 64 + 4);
#ifndef SCAN_NOSTORE
    if (j >= 4) {
      uint4 o; o.x = pack2(s[0], s[1]); o.y = pack2(s[2], s[3]); o.z = pack2(s[4], s[5]); o.w = pack2(s[6], s[7]);
      *(uint4*)(base + (size_t)j * 8192) = o;
    }
#endif
    s[0] = da.x * s[0] + lo_bf(u.x); s[1] = da.y * s[1] + hi_bf(u.x); s[2] = da.z * s[2] + lo_bf(u.y); s[3] = da.w * s[3] + hi_bf(u.y);
    s[4] = dbb.x * s[4] + lo_bf(u.z); s[5] = dbb.y * s[5] + hi_bf(u.z); s[6] = dbb.z * s[6] + lo_bf(u.w); s[7] = dbb.w * s[7] + hi_bf(u.w);
  }
#ifdef SCAN_NOSTORE
  { float* o = p.out + ((size_t)bhd * 128 + e) * 64 + d0;
#pragma unroll
    for (int k = 0; k < 8; ++k) o[k] = s[k]; }
#endif
}

__device__ __forceinline__ void gla_out_item(const Params& p, int b, int h, int n, const bf16_t* __restrict__ pb, bf16_t* __restrict__ mix, char* smem) {
  const int rbase = b * 4096 + n * 64;
  const bf16_t* qe = (const bf16_t*)(smem + 17408);
  const bf16_t* kinv = (const bf16_t*)(smem + 26624);
  bf16_t* att = (bf16_t*)(smem + 35840);
  const bf16_t* vT = (const bf16_t*)(smem + 45056);
  int tid_ = threadIdx.x;
  asm volatile("" : "+v"(tid_));
  const int lane = tid_ & 63, wv = tid_ >> 6, fr = lane & 15, fq = lane >> 4;
  f32x4 o[8];
#pragma unroll
  for (int jn = 0; jn < 8; ++jn) o[jn] = (f32x4){0.f, 0.f, 0.f, 0.f};
  gla_stage_vT(pb, rbase, h, smem);
#pragma unroll 1
  for (int dir = 0; dir < 2; ++dir) {
    gla_prep<true, true, false>(p, pb, rbase, h, dir, n, smem, nullptr);
    __syncthreads();
    f32x4 a4[4];
#pragma unroll
    for (int jn = 0; jn < 4; ++jn) a4[jn] = (f32x4){0.f, 0.f, 0.f, 0.f};
    wave_mma_lds<4>(qe + wv * 16 * LDK, kinv, a4, fr, fq);
    const int row = wv * 16 + fr;
#pragma unroll
    for (int jn = 0; jn < 4; ++jn) {
      float v[4];
#pragma unroll
      for (int r = 0; r < 4; ++r) {
        const int col = jn * 16 + fq * 4 + r;
        const bool keep = dir ? (col >= row) : (col <= row);
        v[r] = keep ? a4[jn][r] : 0.f;
      }
      uint2 pk; pk.x = pack2(v[0], v[1]); pk.y = pack2(v[2], v[3]);
      *(uint2*)(att + row * LDK + jn * 16 + fq * 4) = pk;
    }
    __syncthreads();
    wave_mma_lds<8>(att + wv * 16 * LDK, vT, o, fr, fq);
    const int jj = dir ? 63 - n : n;
    const bf16_t* ST = (const bf16_t*)(p.ws + OFF_EXTRA) + (size_t)(((b * 4 + h) * 2 + dir) * 68 + 4 + jj) * 8192;
    wave_mma_glb<8>(qe + wv * 16 * LDK, ST, o, fr, fq);
    __syncthreads();
  }
  float ss = 0.f;
#pragma unroll
  for (int jn = 0; jn < 8; ++jn) ss += o[jn][0] * o[jn][0] + o[jn][1] * o[jn][1] + o[jn][2] * o[jn][2] + o[jn][3] * o[jn][3];
  ss += __shfl_xor(ss, 16);
  ss += __shfl_xor(ss, 32);
  const float rstd = rsqrtf(ss * (1.f / 128.f) + 1e-6f);
  const int trow = rbase + wv * 16 + fr;
#pragma unroll
  for (int jn = 0; jn < 8; ++jn) {
    const int e = jn * 16 + fq * 4;
    const uint2 gq = *(const uint2*)(pb + (size_t)trow * NIN1P + 1536 + h * 128 + e);
    const float4 hw = *(const float4*)(p.cd_head_norm_w + e);
    const float y0 = o[jn][0] * rstd * hw.x * siluf_(lo_bf(gq.x)), y1 = o[jn][1] * rstd * hw.y * siluf_(hi_bf(gq.x));
    const float y2 = o[jn][2] * rstd * hw.z * siluf_(lo_bf(gq.y)), y3 = o[jn][3] * rstd * hw.w * siluf_(hi_bf(gq.y));
    uint2 pk; pk.x = pack2(y0, y1); pk.y = pack2(y2, y3);
    *(uint2*)(mix + (size_t)trow * 1024 + 512 + h * 128 + e) = pk;
  }
}

__device__ __forceinline__ void fft1_item(const Params& p, int b, int g, int t2, const bf16_t* __restrict__ pb, char* smem) {
  bf16_t* GT = (bf16_t*)smem;
  const bf16_t* T1 = (const bf16_t*)(p.ws + OFF_TAB + 65536);
  const bf16_t* C64 = T1 + 32768;
  const bf16_t* S64 = C64 + 4096;
  const bf16_t* NS64 = C64 + 8192;
  const float* tab = (const float*)(p.ws + OFF_TAB);
  int tid = threadIdx.x;
  asm volatile("" : "+v"(tid));
  const int lane = tid & 63, wv = tid >> 6, fr = lane & 15, fq = lane >> 4;
  {
    f32x4 ga[16];
#pragma unroll
    for (int j = 0; j < 16; ++j) ga[j] = (f32x4){0.f, 0.f, 0.f, 0.f};
    const bf16_t* frow = pb + (size_t)(b * 4096 + (wv * 16 + fr) * 64 + t2) * NIN1P + g * 128 + fq * 8;
#pragma unroll
    for (int s4 = 0; s4 < 4; ++s4) {
      const bf16x8 af = *(const bf16x8*)(frow + s4 * 32);
#pragma unroll
      for (int j = 0; j < 16; ++j) {
        const bf16x8 bfr = *(const bf16x8*)(T1 + (j * 16 + fr) * 128 + s4 * 32 + fq * 8);
        ga[j] = __builtin_amdgcn_mfma_f32_16x16x32_bf16(bfr, af, ga[j], 0, 0, 0);
      }
    }
#pragma unroll
    for (int j = 0; j < 16; ++j)
#pragma unroll
      for (int r = 0; r < 4; ++r) GT[(j * 16 + fq * 4 + r) * LDK + wv * 16 + fr] = f2bf(ga[j][r]);
  }
  __syncthreads();
  {
    f32x4 ar[8], ai[8];
#pragma unroll
    for (int j = 0; j < 8; ++j) { ar[j] = (f32x4){0.f, 0.f, 0.f, 0.f}; ai[j] = (f32x4){0.f, 0.f, 0.f, 0.f}; }
    const int k1 = wv * 16 + fr;
#pragma unroll
    for (int s2 = 0; s2 < 2; ++s2) {
      const bf16x8 cf = *(const bf16x8*)(C64 + k1 * 64 + s2 * 32 + fq * 8);
      const bf16x8 sf = *(const bf16x8*)(S64 + k1 * 64 + s2 * 32 + fq * 8);
      const bf16x8 nsf = *(const bf16x8*)(NS64 + k1 * 64 + s2 * 32 + fq * 8);
#pragma unroll
      for (int j = 0; j < 8; ++j) {
        const bf16x8 grf = *(const bf16x8*)(GT + (j * 16 + fr) * LDK + s2 * 32 + fq * 8);
        const bf16x8 gif = *(const bf16x8*)(GT + (128 + j * 16 + fr) * LDK + s2 * 32 + fq * 8);
        ar[j] = __builtin_amdgcn_mfma_f32_16x16x32_bf16(grf, cf, ar[j], 0, 0, 0);
        ar[j] = __builtin_amdgcn_mfma_f32_16x16x32_bf16(gif, sf, ar[j], 0, 0, 0);
        ai[j] = __builtin_amdgcn_mfma_f32_16x16x32_bf16(gif, cf, ai[j], 0, 0, 0);
        ai[j] = __builtin_amdgcn_mfma_f32_16x16x32_bf16(grf, nsf, ai[j], 0, 0, 0);
      }
    }
    const int tw = k1 * t2;
    const float tc = tab[384 + tw], ts = tab[4480 + tw];
    bf16_t* apr = (bf16_t*)p.out + ((size_t)((b * 4 + g) * 64 + k1) * 64 + t2) * 128;
    bf16_t* api = apr + 16777216;
#pragma unroll
    for (int j = 0; j < 8; ++j) {
      uint2 pr, pi;
      pr.x = pack2(ar[j][0] * tc + ai[j][0] * ts, ar[j][1] * tc + ai[j][1] * ts);
      pr.y = pack2(ar[j][2] * tc + ai[j][2] * ts, ar[j][3] * tc + ai[j][3] * ts);
      pi.x = pack2(ai[j][0] * tc - ar[j][0] * ts, ai[j][1] * tc - ar[j][1] * ts);
      pi.y = pack2(ai[j][2] * tc - ar[j][2] * ts, ai[j][3] * tc - ar[j][3] * ts);
      *(uint2*)(apr + j * 16 + fq * 4) = pr;
      *(uint2*)(api + j * 16 + fq * 4) = pi;
    }
  }
  __syncthreads();
}

__device__ __forceinline__ void fft2_item(const Params& p, int b, int g, int k1, bf16_t* __restrict__ mix, char* smem) {
  bf16_t* ArT = (bf16_t*)smem;
  bf16_t* AiT = ArT + 128 * LDK;
  const bf16_t* C64 = (const bf16_t*)(p.ws + OFF_TAB + 65536) + 32768;
  const bf16_t* S64 = C64 + 4096;
  const bf16_t* apr = (const bf16_t*)p.out + (size_t)((b * 4 + g) * 64 + k1) * 64 * 128;
  const bf16_t* api = apr + 16777216;
  int tid = threadIdx.x;
  asm volatile("" : "+v"(tid));
#pragma unroll
  for (int i = 0; i < 4; ++i) {
    const int idx = tid + i * 256, t2 = idx & 63, m8 = idx >> 6;
    const uint4 u = *(const uint4*)(apr + t2 * 128 + m8 * 8);
    const uint4 v = *(const uint4*)(api + t2 * 128 + m8 * 8);
    bf16_t* dr = ArT + (m8 * 8) * LDK + t2;
    bf16_t* di = AiT + (m8 * 8) * LDK + t2;
    dr[0 * LDK] = (bf16_t)(u.x & 0xffff); dr[1 * LDK] = (bf16_t)(u.x >> 16); dr[2 * LDK] = (bf16_t)(u.y & 0xffff); dr[3 * LDK] = (bf16_t)(u.y >> 16);
    dr[4 * LDK] = (bf16_t)(u.z & 0xffff); dr[5 * LDK] = (bf16_t)(u.z >> 16); dr[6 * LDK] = (bf16_t)(u.w & 0xffff); dr[7 * LDK] = (bf16_t)(u.w >> 16);
    di[0 * LDK] = (bf16_t)(v.x & 0xffff); di[1 * LDK] = (bf16_t)(v.x >> 16); di[2 * LDK] = (bf16_t)(v.y & 0xffff); di[3 * LDK] = (bf16_t)(v.y >> 16);
    di[4 * LDK] = (bf16_t)(v.z & 0xffff); di[5 * LDK] = (bf16_t)(v.z >> 16); di[6 * LDK] = (bf16_t)(v.w & 0xffff); di[7 * LDK] = (bf16_t)(v.w >> 16);
  }
  __syncthreads();
  const int lane = tid & 63, wv = tid >> 6, fr = lane & 15, fq = lane >> 4;
  const int k2 = wv * 16 + fr;
  f32x4 x[8];
#pragma unroll
  for (int j = 0; j < 8; ++j) x[j] = (f32x4){0.f, 0.f, 0.f, 0.f};
#pragma unroll
  for (int s2 = 0; s2 < 2; ++s2) {
    const bf16x8 cf = *(const bf16x8*)(C64 + k2 * 64 + s2 * 32 + fq * 8);
    const bf16x8 sf = *(const bf16x8*)(S64 + k2 * 64 + s2 * 32 + fq * 8);
#pragma unroll
    for (int j = 0; j < 8; ++j) {
      const bf16x8 rf = *(const bf16x8*)(ArT + (j * 16 + fr) * LDK + s2 * 32 + fq * 8);
      const bf16x8 jf = *(const bf16x8*)(AiT + (j * 16 + fr) * LDK + s2 * 32 + fq * 8);
      x[j] = __builtin_amdgcn_mfma_f32_16x16x32_bf16(rf, cf, x[j], 0, 0, 0);
      x[j] = __builtin_amdgcn_mfma_f32_16x16x32_bf16(jf, sf, x[j], 0, 0, 0);
    }
  }
  const float scale = 0.0013810679320049757f;
  bf16_t* orow = mix + (size_t)(b * 4096 + k1 + 64 * k2) * 1024 + g * 128;
#pragma unroll
  for (int j = 0; j < 8; ++j) {
    uint2 pk; pk.x = pack2(x[j][0] * scale, x[j][1] * scale); pk.y = pack2(x[j][2] * scale, x[j][3] * scale);
    *(uint2*)(orow + j * 16 + fq * 4) = pk;
  }
  __syncthreads();
}

__device__ __forceinline__ void phase_mix1a(const Params& p, char* smem) {
  const bf16_t* pb = (const bf16_t*)(p.ws + OFF_BIG);
  const int n_kv = 64 * 68, n_f1 = 8 * 4 * 64;
  for (int it = blockIdx.x; it < n_kv + n_f1; it += gridDim.x) {
    if (it < n_kv) { const int bhd = it / 68, j = it % 68; gla_kv_item(p, bhd >> 3, (bhd >> 1) & 3, bhd & 1, j, pb, smem); }
    else { int t = it - n_kv; fft1_item(p, t >> 8, (t >> 6) & 3, t & 63, pb, smem); }
  }
}

__device__ __forceinline__ void phase_mix1b(const Params& p, char* smem) {
  bf16_t* mix = (bf16_t*)(p.ws + OFF_HM);
  const int n_scan = 256, n_f2 = 8 * 4 * 64;
  for (int it = blockIdx.x; it < n_scan + n_f2; it += gridDim.x) {
#ifndef NO_SCAN
    if (it < n_scan) gla_scan_item(p, it >> 2, it & 3); else
#endif
    { int t = it - n_scan; if (t >= 0) fft2_item(p, t >> 8, (t >> 6) & 3, t & 63, mix, smem); }
  }
}

__device__ __forceinline__ void phase_mix1c(const Params& p, char* smem) {
  const bf16_t* pb = (const bf16_t*)(p.ws + OFF_BIG);
  bf16_t* mix = (bf16_t*)(p.ws + OFF_HM);
  for (int it = blockIdx.x; it < 2048; it += gridDim.x) gla_out_item(p, it >> 8, (it >> 6) & 3, it & 63, pb, mix, smem);
}

#ifndef STOP_AFTER
#define STOP_AFTER 107
#define DUMP_OB 1.0f
#define DUMP_AP 0.0f
#endif
__device__ __forceinline__ void dump_bf16(const bf16_t* buf, int ld, int ncols, float* out) {
  for (size_t idx = (size_t)blockIdx.x * NT + threadIdx.x; idx < (size_t)ROWS_L * 1024; idx += (size_t)gridDim.x * NT) {
    const int r = (int)(idx >> 10), c = (int)(idx & 1023);
    float s = 0.f;
    for (int cc = c; cc < ncols; cc += 1024) {
      s += bf2f(buf[(size_t)r * ld + cc]);
      if (r < ROWS_C) s += bf2f(buf[(size_t)(r + ROWS_L) * ld + cc]);
    }
    out[idx] = s;
  }
}
__device__ __forceinline__ void dump_f32(const float* buf, float* out) {
  for (size_t idx = (size_t)blockIdx.x * NT + threadIdx.x; idx < (size_t)ROWS_L * 1024; idx += (size_t)gridDim.x * NT) {
    const int r = (int)(idx >> 10);
    float s = buf[idx];
    if (r < ROWS_C) s += buf[idx + (size_t)ROWS_L * 1024];
    out[idx] = s;
  }
}

#define XB_XCNT(j) (256 + 64 * (j))
#define XB_XSUB(j) (1280 + 64 * (j))
#define XB_XGEN(j) (2304 + 64 * (j))
#define XB_TOP 3328
#define XB_TOPGEN 3392
struct BarState { unsigned x, nloc, nx; };
__device__ __forceinline__ unsigned xb_ld(unsigned* p) { return __hip_atomic_load(p, __ATOMIC_RELAXED, __HIP_MEMORY_SCOPE_AGENT); }
__device__ __forceinline__ unsigned xb_add(unsigned* p, unsigned v) { return __hip_atomic_fetch_add(p, v, __ATOMIC_RELAXED, __HIP_MEMORY_SCOPE_AGENT); }
__device__ __forceinline__ void grid_barrier_post(unsigned* bar, BarState& st) {
  st.x = (unsigned)__builtin_amdgcn_s_getreg((3 << 11) | 20) & 0xFu;
  st.nloc = 0u; st.nx = 0u;
  if (threadIdx.x == 0) (void)xb_add(&bar[XB_XCNT(st.x)], 1u);
}
__device__ __forceinline__ void grid_barrier(unsigned* bar, BarState& st, const float*, float*) {
  asm volatile("s_waitcnt vmcnt(0) lgkmcnt(0)" ::: "memory");
  __syncthreads();
  if (threadIdx.x == 0) {
    if (st.nloc == 0u) {
      const unsigned G = gridDim.x;
      for (;;) {
        unsigned sum = 0u, cnt = 0u, mine = 0u;
#pragma unroll
        for (unsigned j = 0; j < 16; ++j) { const unsigned c = xb_ld(&bar[XB_XCNT(j)]); sum += c; cnt += (c > 0u) ? 1u : 0u; mine = (j == st.x) ? c : mine; }
        if (sum == G) { st.nloc = mine; st.nx = cnt; break; }
        __builtin_amdgcn_s_sleep(1);
      }
    }
    const unsigned old = xb_add(&bar[XB_XSUB(st.x)], 1u);
    const unsigned gen = old / st.nloc;
    if (old + 1u == (gen + 1u) * st.nloc) {
      __builtin_amdgcn_fence(__ATOMIC_RELEASE, "agent");
      asm volatile("s_waitcnt vmcnt(0)" ::: "memory");
      const unsigned og = xb_add(&bar[XB_TOP], 1u);
      const unsigned tg = og / st.nx;
      if (og + 1u == (tg + 1u) * st.nx) (void)xb_add(&bar[XB_TOPGEN], 1u);
      else while (xb_ld(&bar[XB_TOPGEN]) == tg) __builtin_amdgcn_s_sleep(1);
      __builtin_amdgcn_fence(__ATOMIC_ACQUIRE, "agent");
      (void)xb_add(&bar[XB_XGEN(st.x)], 1u);
      asm volatile("s_waitcnt vmcnt(0)" ::: "memory");
    } else {
      while (xb_ld(&bar[XB_XGEN(st.x)]) == gen) __builtin_amdgcn_s_sleep(1);
      __builtin_amdgcn_fence(__ATOMIC_ACQUIRE, "agent");
      asm volatile("s_waitcnt vmcnt(0)" ::: "memory");
    }
  }
  __syncthreads();
}

constexpr int NPHASE = 16;
#ifndef ONLY
#define ONLY -1
#endif
#define PH_EN(n) (ONLY < 0 || ONLY == (n))

template <int PH>
__device__ __forceinline__ void run_phase(const Params& p, char* smem) {
  const float* mod0 = (const float*)(p.ws + OFF_MOD);
  const float* mod1 = mod0 + 9 * MODN;
  float* xres = (float*)(p.ws + OFF_XRES);
  float* xctx = xres + (size_t)ROWS_L * 1024;
  bf16_t* hm = (bf16_t*)(p.ws + OFF_HM);
  bf16_t* big = (bf16_t*)(p.ws + OFF_BIG);
  if (PH == 0) phase_prep(p, smem);
  if (PH == 1) phase_norm(p.x, p.ctx, p.norm_mix_w, mod0, 0, 1024, hm, ROWS);
  if (PH == 2) { Epi e{}; e.C = big; e.ldc = NIN0; e.gelu_cols = 1024;
    gemm_phase<0>(hm, 1024, (const bf16_t*)(p.ws + OFF_WIN0), 1024, ROWS, NIN0, smem, e); }
  if (PH == 3) phase_mix0(p, smem);
  if (PH == 4) { Epi e{}; e.src_lat = p.x; e.src_ctx = p.ctx; e.dst = xres; e.gate = mod0 + 2048;
    gemm_phase<1>(hm, 1024, (const bf16_t*)(p.ws + OFF_WOUT0), 1024, ROWS, 1024, smem, e); }
  if (PH == 5) phase_norm(xres, xctx, p.norm_ffn_w, mod0, 3072, 4096, hm, ROWS);
  if (PH == 6) { Epi e{}; e.C = big; e.ldc = FFN;
    gemm_phase<2>(hm, 1024, (const bf16_t*)(p.ws + OFF_WGU0), 1024, ROWS, 2 * FFN, smem, e); }
  if (PH == 7) { Epi e{}; e.src_lat = xres; e.src_ctx = xctx; e.dst = xres; e.gate = mod0 + 5120;
    gemm_phase<1>(big, FFN, (const bf16_t*)(p.ws + OFF_WD0), FFN, ROWS, 1024, smem, e); }
  if (PH == 8) phase_norm(xres, xctx, p.norm_mix_w + 1024, mod1, 0, 1024, hm, ROWS);
  if (PH == 9) { Epi e{}; e.C = big; e.ldc = NIN1P; e.gelu_cols = 0;
    gemm_phase<0>(hm, 1024, (const bf16_t*)(p.ws + OFF_WIN1), 1024, ROWS, NIN1P, smem, e); }
  if (PH == 10) phase_mix1a(p, smem);
  if (PH == 11) phase_mix1b(p, smem);
  if (PH == 12) phase_mix1c(p, smem);
  if (PH == 13) { Epi e{}; e.src_lat = xres; e.src_ctx = xctx; e.dst = xres; e.gate = mod1 + 2048;
    gemm_phase<1>(hm, 1024, (const bf16_t*)(p.ws + OFF_WOUT1), 1024, ROWS_L, 1024, smem, e); }
  if (PH == 14) phase_norm(xres, xctx, p.norm_ffn_w + 1024, mod1, 3072, 4096, hm, ROWS_L);
  if (PH == 15) { Epi e{}; e.C = big; e.ldc = FFN;
    gemm_phase<2>(hm, 1024, (const bf16_t*)(p.ws + OFF_WGU1), 1024, ROWS_L, 2 * FFN, smem, e); }
  if (PH == 16) { Epi e{}; e.src_lat = xres; e.src_ctx = xctx; e.dst = xres; e.gate = mod1 + 5120;
    gemm_phase<1>(big, FFN, (const bf16_t*)(p.ws + OFF_WD1), FFN, ROWS_L, 1024, smem, e); }
  if (PH == 17) phase_final_norm(xres, p.final_norm_w, p.out);
}
constexpr int NPH = 18;

#ifndef MULTI_LAUNCH
#define MULTI_LAUNCH 0
#endif

#if MULTI_LAUNCH
template <int PH>
__global__ void __launch_bounds__(NT, 2) phase_kernel(Params p) {
  __shared__ __attribute__((aligned(16))) char smem[65536];
  run_phase<PH>(p, smem);
}
template <int PH>
static void launch_phases(const Params& p, int grid, hipStream_t stream) {
  phase_kernel<PH><<<dim3(grid), dim3(NT), 0, stream>>>(p);
  if constexpr (PH + 1 < NPH) launch_phases<PH + 1>(p, grid, stream);
}
#else
template <int PH>
__device__ __forceinline__ void run_all(const Params& p, char* smem, unsigned* bar, BarState& gen) {
  run_phase<PH>(p, smem);
#ifdef DOUBLE_MASK
  if constexpr ((DOUBLE_MASK >> PH) & 1) { grid_barrier(bar, gen, p.x, p.out); run_phase<PH>(p, smem); }
#endif
  if constexpr (PH + 1 < NPH) { grid_barrier(bar, gen, p.x, p.out); run_all<PH + 1>(p, smem, bar, gen); }
}
__global__ void __launch_bounds__(NT, 2) fwd_kernel(Params p) {
  __shared__ __attribute__((aligned(16))) char smem[65536];
  unsigned* bar = (unsigned*)(p.ws + OFF_BAR);
  BarState gen;
  grid_barrier_post(bar, gen);
  run_all<0>(p, smem, bar, gen);
}
#endif

extern "C" void kernel_launch(void* const* d_in, const int* in_sizes, int n_in, void* d_out, int out_size, void* d_ws, size_t ws_size,
                              hipStream_t stream) {
  if (ws_size < WS_NEED) { fprintf(stderr, "workspace too small: %zu\n", ws_size); return; }
  Params p{};
  const float** pp = (const float**)&p;
  for (int i = 0; i < 25; ++i) pp[i] = (const float*)d_in[i];
  p.out = (float*)d_out;
  p.ws = (char*)d_ws;
#if MULTI_LAUNCH
  launch_phases<0>(p, 512, stream);
#else
  static int grid_blocks = 0;
  if (!grid_blocks) {
    int dev = 0, cus = 0, per_cu = 0;
    (void)hipGetDevice(&dev);
    (void)hipDeviceGetAttribute(&cus, hipDeviceAttributeMultiprocessorCount, dev);
    (void)hipOccupancyMaxActiveBlocksPerMultiprocessor(&per_cu, fwd_kernel, NT, 0);
    if (per_cu > 2) per_cu = 2;
    if (per_cu < 1) per_cu = 1;
    grid_blocks = cus * per_cu;
  }
  (void)hipMemsetAsync((char*)d_ws + OFF_BAR, 0, 16384, stream);
  void* args[] = {&p};
  hipError_t err = hipLaunchCooperativeKernel((void*)fwd_kernel, dim3(grid_blocks), dim3(NT), args, 0, stream);
  if (err != hipSuccess) fprintf(stderr, "cooperative launch failed: %s (grid %d)\n", hipGetErrorString(err), grid_blocks);
#endif
}
```

```cpp
#include <hip/hip_runtime.h>
#include <hip/hip_cooperative_groups.h>
#include <cstdio>
namespace cg = cooperative_groups;

typedef unsigned short bf16_t;
typedef short bf16x8 __attribute__((ext_vector_type(8)));
typedef float f32x4 __attribute__((ext_vector_type(4)));

#define NT 256
constexpr int D = 1024, SEQ = 4096, NB = 8, CTXL = 256;
constexpr int ROWS_L = NB * SEQ;
constexpr int ROWS_C = NB * CTXL;
constexpr int ROWS = ROWS_L + ROWS_C;
constexpr int FFN = 2816;
constexpr int NIN0 = 2560, NIN1 = 2080, NIN1P = 2176;
constexpr int MODN = 6144;
constexpr int LDK = 72;

constexpr size_t MiB = (size_t)1 << 20;
constexpr size_t OFF_WIN0 = 0, OFF_WOUT0 = 5 * MiB, OFF_WGU0 = 7 * MiB, OFF_WD0 = 18 * MiB;
constexpr size_t OFF_WIN1 = 24 * MiB, OFF_WOUT1 = 29 * MiB, OFF_WGU1 = 31 * MiB, OFF_WD1 = 42 * MiB;
constexpr size_t OFF_MOD = 48 * MiB;
constexpr size_t OFF_TAB = 48 * MiB + 512 * 1024;
constexpr size_t OFF_BAR = 48 * MiB + 768 * 1024;
constexpr size_t OFF_XRES = 49 * MiB;
constexpr size_t OFF_HM = 185 * MiB;
constexpr size_t OFF_BIG = 253 * MiB;
constexpr size_t OFF_APR = OFF_BIG + 145 * MiB;
constexpr size_t OFF_API = OFF_BIG + 161 * MiB;
constexpr size_t OFF_EXTRA = 440 * MiB;
constexpr size_t WS_NEED = 508 * MiB;

struct Params {
  const float *x, *c, *ctx, *c_ctx, *ada_w, *ada_b, *norm_mix_w, *norm_ffn_w, *ffn_w_gate, *ffn_w_up, *ffn_w_down;
  const float *ab_w_in, *ab_w_out, *ab_sgu_norm_w, *ab_sgu_w, *ab_sgu_b, *ab_rel_bias;
  const float *cd_w_in, *cd_w_out, *cd_dw_f, *cd_db_f, *cd_dw_b, *cd_db_b, *cd_head_norm_w, *final_norm_w;
  float* out;
  char* ws;
};

__device__ __forceinline__ bf16_t f2bf(float f) {
  unsigned u = __float_as_uint(f);
  u += 0x7fffu + ((u >> 16) & 1u);
  return (bf16_t)(u >> 16);
}
__device__ __forceinline__ float bf2f(bf16_t h) { return __uint_as_float(((unsigned)h) << 16); }
__device__ __forceinline__ unsigned pack2(float a, float b) { return (unsigned)f2bf(a) | ((unsigned)f2bf(b) << 16); }
__device__ __forceinline__ float lo_bf(unsigned u) { return __uint_as_float(u << 16); }
__device__ __forceinline__ float hi_bf(unsigned u) { return __uint_as_float(u & 0xffff0000u); }
__device__ __forceinline__ float sigmoidf_(float x) { return 1.f / (1.f + __expf(-x)); }
__device__ __forceinline__ float siluf_(float x) { return x * sigmoidf_(x); }
__device__ __forceinline__ float geluf_(float x) {
  float u = 0.7978845608028654f * (x + 0.044715f * x * x * x);
  return x * sigmoidf_(2.f * u);
}
__device__ __forceinline__ float wave_sum(float v) {
#pragma unroll
  for (int o = 32; o > 0; o >>= 1) v += __shfl_xor(v, o);
  return v;
}
__device__ __forceinline__ float cos_rev(float r) { return __builtin_amdgcn_cosf(r); }
__device__ __forceinline__ float sin_rev(float r) { return __builtin_amdgcn_sinf(r); }

__device__ __forceinline__ void wt_tile(const float* __restrict__ src, const float* __restrict__ src2, int N, int ldsrc, bf16_t* __restrict__ dst,
                        int lddst, int kt, int ntile, int mode, float* tile) {
  const int tid = threadIdx.x;
#pragma unroll
  for (int i = 0; i < 4; ++i) {
    const int kk = (tid >> 4) + i * 16, j4 = (tid & 15) * 4;
    float4 v = make_float4(0.f, 0.f, 0.f, 0.f);
    if (mode == 0) {
      const int col = ntile * 64 + j4;
      if (col < N) v = *(const float4*)(src + (size_t)(kt * 64 + kk) * ldsrc + col);
    } else {
      const int col = ntile * 32 + (j4 & 31);
      const float* sp = (j4 < 32) ? src : src2;
      v = *(const float4*)(sp + (size_t)(kt * 64 + kk) * ldsrc + col);
    }
    tile[(j4 + 0) * 65 + kk] = v.x; tile[(j4 + 1) * 65 + kk] = v.y; tile[(j4 + 2) * 65 + kk] = v.z; tile[(j4 + 3) * 65 + kk] = v.w;
  }
  __syncthreads();
#pragma unroll
  for (int i = 0; i < 2; ++i) {
    const int e = tid + i * 256, j = e >> 3, k8 = (e & 7) * 8;
    const float* tp = tile + j * 65 + k8;
    uint4 pk; pk.x = pack2(tp[0], tp[1]); pk.y = pack2(tp[2], tp[3]); pk.z = pack2(tp[4], tp[5]); pk.w = pack2(tp[6], tp[7]);
    *(uint4*)(dst + (size_t)(ntile * 64 + j) * lddst + kt * 64 + k8) = pk;
  }
  __syncthreads();
}

__device__ __forceinline__ void mod_item(const Params& p, int item, float* sm) {
  const int l = item / 96, cgp = item % 96;
  const int tid = threadIdx.x, nn = tid & 63, ks = tid >> 6;
  float* sil = sm;
  float* red = sm + 4 * 9 * 256;
  for (int e = tid; e < 9 * 1024; e += NT) {
    int v = e >> 10, k = e & 1023;
    float cv = (v < 8) ? p.c[v * 1024 + k] : p.c_ctx[k];
    sil[((k >> 8) * 9 + v) * 256 + (k & 255)] = siluf_(cv);
  }
  __syncthreads();
  float acc[9];
#pragma unroll
  for (int v = 0; v < 9; ++v) acc[v] = 0.f;
  const float* w = p.ada_w + (size_t)l * 1024 * MODN + cgp * 64 + nn;
#pragma unroll 16
  for (int k = 0; k < 256; ++k) {
    float wv = w[(size_t)(ks * 256 + k) * MODN];
#pragma unroll
    for (int v = 0; v < 9; ++v) acc[v] += sil[(ks * 9 + v) * 256 + k] * wv;
  }
#pragma unroll
  for (int v = 0; v < 9; ++v) red[(ks * 9 + v) * 64 + nn] = acc[v];
  __syncthreads();
  float* mod = (float*)(p.ws + OFF_MOD);
  for (int e = tid; e < 9 * 64; e += NT) {
    int v = e >> 6, n = e & 63;
    float s = red[(0 * 9 + v) * 64 + n] + red[(1 * 9 + v) * 64 + n] + red[(2 * 9 + v) * 64 + n] + red[(3 * 9 + v) * 64 + n];
    mod[((size_t)l * 9 + v) * MODN + cgp * 64 + n] = s + p.ada_b[l * MODN + cgp * 64 + n];
  }
  __syncthreads();
}

__device__ __forceinline__ void phase_prep(const Params& p, char* smem) {
  float* sm = (float*)smem;
  bf16_t* W = (bf16_t*)p.ws;
  const int n_in0 = 16 * 40, n_out = 16 * 16, n_gu = 16 * 88, n_d = 44 * 16, n_in1 = 16 * 34;
  const int c0 = n_in0, c1 = c0 + n_out, c2 = c1 + n_gu, c3 = c2 + n_d, c4 = c3 + n_in1, c5 = c4 + n_out, c6 = c5 + n_gu, c7 = c6 + n_d;
  const int total = c7 + 192 + 1;
  for (int it = blockIdx.x; it < total; it += gridDim.x) {
    if (it < c0) { int t = it; wt_tile(p.ab_w_in, nullptr, NIN0, NIN0, (bf16_t*)(p.ws + OFF_WIN0), 1024, t / 40, t % 40, 0, sm); }
    else if (it < c1) { int t = it - c0; wt_tile(p.ab_w_out, nullptr, 1024, 1024, (bf16_t*)(p.ws + OFF_WOUT0), 1024, t / 16, t % 16, 0, sm); }
    else if (it < c2) { int t = it - c1; wt_tile(p.ffn_w_gate, p.ffn_w_up, FFN, FFN, (bf16_t*)(p.ws + OFF_WGU0), 1024, t / 88, t % 88, 1, sm); }
    else if (it < c3) { int t = it - c2; wt_tile(p.ffn_w_down, nullptr, 1024, 1024, (bf16_t*)(p.ws + OFF_WD0), FFN, t / 16, t % 16, 0, sm); }
    else if (it < c4) { int t = it - c3; wt_tile(p.cd_w_in, nullptr, NIN1, NIN1, (bf16_t*)(p.ws + OFF_WIN1), 1024, t / 34, t % 34, 0, sm); }
    else if (it < c5) { int t = it - c4; wt_tile(p.cd_w_out, nullptr, 1024, 1024, (bf16_t*)(p.ws + OFF_WOUT1), 1024, t / 16, t % 16, 0, sm); }
    else if (it < c6) { int t = it - c5; wt_tile(p.ffn_w_gate + (size_t)1024 * FFN, p.ffn_w_up + (size_t)1024 * FFN, FFN, FFN, (bf16_t*)(p.ws + OFF_WGU1), 1024, t / 88, t % 88, 1, sm); }
    else if (it < c7) { int t = it - c6; wt_tile(p.ffn_w_down + (size_t)FFN * 1024, nullptr, 1024, 1024, (bf16_t*)(p.ws + OFF_WD1), FFN, t / 16, t % 16, 0, sm); }
    else if (it < c7 + 192) { mod_item(p, it - c7, sm); }
    else {
      float* tab = (float*)(p.ws + OFF_TAB);
      for (int e = threadIdx.x; e < 128; e += NT) { tab[e] = cos_rev(e / 128.f); tab[128 + e] = sin_rev(e / 128.f); }
      for (int e = threadIdx.x; e < 64; e += NT) { tab[256 + e] = cos_rev(e / 64.f); tab[320 + e] = sin_rev(e / 64.f); }
      for (int e = threadIdx.x; e < 4096; e += NT) { tab[384 + e] = cos_rev(e / 4096.f); tab[4480 + e] = sin_rev(e / 4096.f); }
      for (int e = threadIdx.x; e < 1024; e += NT) {
        int pos = e >> 4, i = e & 15;
        float inv = __expf(-(float)i / 16.f * 9.210340371976184f);
        float ang = (float)pos * inv;
        float rev = ang * 0.15915494309189535f;
        rev = rev - floorf(rev);
        tab[8576 + e] = cos_rev(rev); tab[9600 + e] = sin_rev(rev);
      }
      bf16_t* t1 = (bf16_t*)(p.ws + OFF_TAB + 65536);
      for (int e = threadIdx.x; e < 32768; e += NT) {
        const int n = e >> 7, cidx = e & 127;
        const float rev = (float)((cidx * (n & 127)) & 127) / 128.f;
        t1[e] = f2bf(n < 128 ? cos_rev(rev) : -sin_rev(rev));
      }
      bf16_t* c64 = t1 + 32768;
      for (int e = threadIdx.x; e < 4096; e += NT) {
        const float rev = (float)(((e >> 6) * (e & 63)) & 63) / 64.f;
        const float cv = cos_rev(rev), sv = sin_rev(rev);
        c64[e] = f2bf(cv); c64[4096 + e] = f2bf(sv); c64[8192 + e] = f2bf(-sv);
      }
    }
  }
}

__device__ __forceinline__ void phase_norm(const float* __restrict__ src_lat, const float* __restrict__ src_ctx, const float* __restrict__ w,
                           const float* __restrict__ modl  , int sh_off, int sc_off, bf16_t* __restrict__ dst, int nrows) {
  const int lane = threadIdx.x & 63, wid = threadIdx.x >> 6;
  for (int r = blockIdx.x * 4 + wid; r < nrows; r += gridDim.x * 4) {
    const float* s = (r < ROWS_L) ? src_lat + (size_t)r * 1024 : src_ctx + (size_t)(r - ROWS_L) * 1024;
    const int vec = (r < ROWS_L) ? (r >> 12) : 8;
    const float* mv = modl + (size_t)vec * MODN;
    float4 v[4];
    float ss = 0.f;
#pragma unroll
    for (int i = 0; i < 4; ++i) {
      v[i] = *(const float4*)(s + i * 256 + lane * 4);
      ss += v[i].x * v[i].x + v[i].y * v[i].y + v[i].z * v[i].z + v[i].w * v[i].w;
    }
    ss = wave_sum(ss);
    const float rstd = rsqrtf(ss * (1.f / 1024.f) + 1e-6f);
#pragma unroll
    for (int i = 0; i < 4; ++i) {
      const int cidx = i * 256 + lane * 4;
      float4 wv = *(const float4*)(w + cidx);
      float4 sc = *(const float4*)(mv + sc_off + cidx);
      float4 sh = *(const float4*)(mv + sh_off + cidx);
      float o0 = v[i].x * rstd * wv.x * (1.f + sc.x) + sh.x;
      float o1 = v[i].y * rstd * wv.y * (1.f + sc.y) + sh.y;
      float o2 = v[i].z * rstd * wv.z * (1.f + sc.z) + sh.z;
      float o3 = v[i].w * rstd * wv.w * (1.f + sc.w) + sh.w;
      uint2 pk; pk.x = pack2(o0, o1); pk.y = pack2(o2, o3);
      *(uint2*)(dst + (size_t)r * 1024 + cidx) = pk;
    }
  }
}

__device__ __forceinline__ void phase_final_norm(const float* __restrict__ src, const float* __restrict__ w, float* __restrict__ dst) {
  const int lane = threadIdx.x & 63, wid = threadIdx.x >> 6;
  for (int r = blockIdx.x * 4 + wid; r < ROWS_L; r += gridDim.x * 4) {
    const float* s = src + (size_t)r * 1024;
    float4 v[4];
    float ss = 0.f;
#pragma unroll
    for (int i = 0; i < 4; ++i) {
      v[i] = *(const float4*)(s + i * 256 + lane * 4);
      ss += v[i].x * v[i].x + v[i].y * v[i].y + v[i].z * v[i].z + v[i].w * v[i].w;
    }
    ss = wave_sum(ss);
    const float rstd = rsqrtf(ss * (1.f / 1024.f) + 1e-6f);
#pragma unroll
    for (int i = 0; i < 4; ++i) {
      const int cidx = i * 256 + lane * 4;
      float4 wv = *(const float4*)(w + cidx);
      float4 o; o.x = v[i].x * rstd * wv.x; o.y = v[i].y * rstd * wv.y; o.z = v[i].z * rstd * wv.z; o.w = v[i].w * rstd * wv.w;
      *(float4*)(dst + (size_t)r * 1024 + cidx) = o;
    }
  }
}

struct Epi {
  bf16_t* C; int ldc; int gelu_cols;
  const float* src_lat; const float* src_ctx;
  float* dst;
  const float* gate;
};

template <int EPI>
__device__ __forceinline__ void gemm_phase(const bf16_t* __restrict__ A, int lda, const bf16_t* __restrict__ Bt, int K, int Mrows, int N,
                           char* smem, const Epi ep) {
  constexpr int IM = 8;
  const int tid = threadIdx.x, lane = tid & 63, wid = tid >> 6, wm = wid >> 1, wn = wid & 1;
  const int fr = lane & 15, fq = lane >> 4;
  const int nMt = Mrows / 256, nNt = N / 128, ntiles = nMt * nNt, nk = K / 64;
  const int drow = lane >> 3, dkc = (lane & 7) ^ (lane >> 3);
  const int ko0 = ((fq) ^ (fr & 7)) * 16, ko1 = ((4 + fq) ^ (fr & 7)) * 16;
  const int vb = (int)(blockIdx.x & 7u) * (int)(gridDim.x >> 3) + (int)(blockIdx.x >> 3);
  for (int tile = vb; tile < ntiles; tile += gridDim.x) {
    const int grp = tile / (8 * nNt), wi = tile % (8 * nNt);
    const int mt = grp * 8 + (wi & 7), nt = wi >> 3;
    const int m0 = mt * 256, n0 = nt * 128;
    f32x4 acc[IM][4];
#pragma unroll
    for (int i = 0; i < IM; ++i)
#pragma unroll
      for (int j = 0; j < 4; ++j) acc[i][j] = (f32x4){0.f, 0.f, 0.f, 0.f};
    const bf16_t* gA = A + (size_t)(m0 + wid * 64 + drow) * lda + dkc * 8;
    const bf16_t* gB = Bt + (size_t)(n0 + wid * 32 + drow) * K + dkc * 8;
    auto dma_a = [&](int kt_) {
      char* sb_ = smem + lane * 16;
#pragma unroll
      for (int i = 0; i < 8; ++i)
        __builtin_amdgcn_global_load_lds((const unsigned*)(gA + (size_t)i * 8 * lda + kt_ * 64), (unsigned*)(sb_ + (wid * 8 + i) * 1024), 16, 0, 0);
    };
    auto dma_b = [&](int kt_) {
      char* sb_ = smem + 32768 + (kt_ & 1) * 16384 + lane * 16;
#pragma unroll
      for (int i = 0; i < 4; ++i)
        __builtin_amdgcn_global_load_lds((const unsigned*)(gB + (size_t)i * 8 * K + kt_ * 64), (unsigned*)(sb_ + (wid * 4 + i) * 1024), 16, 0, 0);
    };
    const char* as = smem + (wm * 128 + fr) * 128;
    asm volatile("s_waitcnt vmcnt(0)" ::: "memory");
    __syncthreads();
    dma_a(0); dma_b(0);
    for (int kt = 0; kt < nk; ++kt) {
      asm volatile("s_waitcnt vmcnt(0)" ::: "memory");
      __builtin_amdgcn_s_barrier();
      asm volatile("" ::: "memory");
      if (kt + 1 < nk) dma_b(kt + 1);
      const char* bs = smem + 32768 + (kt & 1) * 16384 + (wn * 64 + fr) * 128;
      bf16x8 af[IM], bfr[4];
#pragma unroll
      for (int j = 0; j < 4; ++j) bfr[j] = *(const bf16x8*)(bs + j * 2048 + ko0);
#pragma unroll
      for (int i = 0; i < IM; ++i) af[i] = *(const bf16x8*)(as + i * 2048 + ko0);
      __builtin_amdgcn_sched_barrier(0);
#pragma unroll
      for (int i = 0; i < IM; ++i)
#pragma unroll
        for (int j = 0; j < 4; ++j) acc[i][j] = __builtin_amdgcn_mfma_f32_16x16x32_bf16(bfr[j], af[i], acc[i][j], 0, 0, 0);
      __builtin_amdgcn_sched_barrier(0);
#pragma unroll
      for (int j = 0; j < 4; ++j) bfr[j] = *(const bf16x8*)(bs + j * 2048 + ko1);
#pragma unroll
      for (int i = 0; i < IM; ++i) af[i] = *(const bf16x8*)(as + i * 2048 + ko1);
      __builtin_amdgcn_sched_barrier(0);
      asm volatile("s_waitcnt lgkmcnt(0)" ::: "memory");
      __builtin_amdgcn_s_barrier();
      asm volatile("" ::: "memory");
      if (kt + 1 < nk) dma_a(kt + 1);
      __builtin_amdgcn_sched_barrier(0);
#pragma unroll
      for (int i = 0; i < IM; ++i)
#pragma unroll
        for (int j = 0; j < 4; ++j) acc[i][j] = __builtin_amdgcn_mfma_f32_16x16x32_bf16(bfr[j], af[i], acc[i][j], 0, 0, 0);
      __builtin_amdgcn_sched_barrier(0);
    }
    if (EPI == 0) {
      const bool do_gelu = n0 < ep.gelu_cols;
#pragma unroll
      for (int i = 0; i < IM; ++i) {
        const int m = m0 + wm * 128 + i * 16 + fr;
#pragma unroll
        for (int j = 0; j < 4; ++j) {
          const int n = n0 + wn * 64 + j * 16 + fq * 4;
          f32x4 v = acc[i][j];
          if (do_gelu) { v[0] = geluf_(v[0]); v[1] = geluf_(v[1]); v[2] = geluf_(v[2]); v[3] = geluf_(v[3]); }
          uint2 pk; pk.x = pack2(v[0], v[1]); pk.y = pack2(v[2], v[3]);
          *(uint2*)(ep.C + (size_t)m * ep.ldc + n) = pk;
        }
      }
    } else if (EPI == 1) {
      const int vec = (m0 < ROWS_L) ? (m0 >> 12) : 8;
      const float* gv = ep.gate + (size_t)vec * MODN;
#pragma unroll
      for (int i = 0; i < IM; ++i) {
        const int m = m0 + wm * 128 + i * 16 + fr;
        const float* srow_p = (m < ROWS_L) ? ep.src_lat + (size_t)m * 1024 : ep.src_ctx + (size_t)(m - ROWS_L) * 1024;
#pragma unroll
        for (int j = 0; j < 4; ++j) {
          const int n = n0 + wn * 64 + j * 16 + fq * 4;
          float4 sv = *(const float4*)(srow_p + n);
          float4 g = *(const float4*)(gv + n);
          float4 o;
          o.x = sv.x + g.x * acc[i][j][0]; o.y = sv.y + g.y * acc[i][j][1];
          o.z = sv.z + g.z * acc[i][j][2]; o.w = sv.w + g.w * acc[i][j][3];
          *(float4*)(ep.dst + (size_t)m * 1024 + n) = o;
        }
      }
    } else {
#pragma unroll
      for (int i = 0; i < IM; ++i) {
        const int m = m0 + wm * 128 + i * 16 + fr;
#pragma unroll
        for (int j = 0; j < 2; ++j) {
          const int n = (n0 >> 1) + wn * 32 + j * 16 + fq * 4;
          f32x4 g = acc[i][j], u = acc[i][j + 2];
          uint2 pk;
          pk.x = pack2(siluf_(g[0]) * u[0], siluf_(g[1]) * u[1]);
          pk.y = pack2(siluf_(g[2]) * u[2], siluf_(g[3]) * u[3]);
          *(uint2*)(ep.C + (size_t)m * ep.ldc + n) = pk;
        }
      }
    }
  }
}

__device__ __forceinline__ void sgu_item(const Params& p, int ck, int g, const bf16_t* __restrict__ pb, bf16_t* __restrict__ mix, char* smem) {
  constexpr int LDV = 136;
  bf16_t* vnT = (bf16_t*)smem;
  int tid = threadIdx.x;
  asm volatile("" : "+v"(tid));
  const int r0 = ck * 128;
  {
    const int q = tid >> 1, half = tid & 1;
    const bf16_t* vrow = pb + (size_t)(r0 + q) * NIN0 + 512 + half * 256;
    float ss = 0.f;
#pragma unroll 4
    for (int i = 0; i < 32; ++i) {
      uint4 u = *(const uint4*)(vrow + i * 8);
      float a;
      a = lo_bf(u.x); ss += a * a; a = hi_bf(u.x); ss += a * a;
      a = lo_bf(u.y); ss += a * a; a = hi_bf(u.y); ss += a * a;
      a = lo_bf(u.z); ss += a * a; a = hi_bf(u.z); ss += a * a;
      a = lo_bf(u.w); ss += a * a; a = hi_bf(u.w); ss += a * a;
    }
    ss += __shfl_xor(ss, 1);
    const float rstd = rsqrtf(ss * (1.f / 512.f) + 1e-6f);
    const bf16_t* vg = pb + (size_t)(r0 + q) * NIN0 + 512 + g * 128 + half * 64;
    const float* nw = p.ab_sgu_norm_w + g * 128 + half * 64;
#pragma unroll 2
    for (int i = 0; i < 8; ++i) {
      const uint4 u = *(const uint4*)(vg + i * 8);
      const float4 w0 = *(const float4*)(nw + i * 8), w1 = *(const float4*)(nw + i * 8 + 4);
      bf16_t* dp = vnT + (half * 64 + i * 8) * LDV + q;
      dp[0 * LDV] = f2bf(lo_bf(u.x) * rstd * w0.x); dp[1 * LDV] = f2bf(hi_bf(u.x) * rstd * w0.y);
      dp[2 * LDV] = f2bf(lo_bf(u.y) * rstd * w0.z); dp[3 * LDV] = f2bf(hi_bf(u.y) * rstd * w0.w);
      dp[4 * LDV] = f2bf(lo_bf(u.z) * rstd * w1.x); dp[5 * LDV] = f2bf(hi_bf(u.z) * rstd * w1.y);
      dp[6 * LDV] = f2bf(lo_bf(u.w) * rstd * w1.z); dp[7 * LDV] = f2bf(hi_bf(u.w) * rstd * w1.w);
    }
  }
  __syncthreads();
  {
    const int lane = tid & 63, wv = tid >> 6, fr = lane & 15, fq = lane >> 4;
    const float* W = p.ab_sgu_w + (size_t)g * 128 * 128;
    f32x4 acc[2][8];
#pragma unroll
    for (int i = 0; i < 2; ++i)
#pragma unroll
      for (int j = 0; j < 8; ++j) acc[i][j] = (f32x4){0.f, 0.f, 0.f, 0.f};
#pragma unroll
    for (int s4 = 0; s4 < 4; ++s4) {
      bf16x8 af[2];
#pragma unroll
      for (int i = 0; i < 2; ++i) {
        const float* wp = W + (wv * 32 + i * 16 + fr) * 128 + s4 * 32 + fq * 8;
        const float4 a0 = *(const float4*)wp, a1 = *(const float4*)(wp + 4);
        uint4 pk; pk.x = pack2(a0.x, a0.y); pk.y = pack2(a0.z, a0.w); pk.z = pack2(a1.x, a1.y); pk.w = pack2(a1.z, a1.w);
        af[i] = *(bf16x8*)&pk;
      }
#pragma unroll
      for (int j = 0; j < 8; ++j) {
        const bf16x8 bfr = *(const bf16x8*)(vnT + (j * 16 + fr) * LDV + s4 * 32 + fq * 8);
        acc[0][j] = __builtin_amdgcn_mfma_f32_16x16x32_bf16(bfr, af[0], acc[0][j], 0, 0, 0);
        acc[1][j] = __builtin_amdgcn_mfma_f32_16x16x32_bf16(bfr, af[1], acc[1][j], 0, 0, 0);
      }
    }
#pragma unroll
    for (int i = 0; i < 2; ++i) {
      const int pp = wv * 32 + i * 16 + fr;
      const float bias = p.ab_sgu_b[g * 128 + pp];
#pragma unroll
      for (int j = 0; j < 8; ++j) {
        const int cc = j * 16 + fq * 4;
        const uint2 uu = *(const uint2*)(pb + (size_t)(r0 + pp) * NIN0 + g * 128 + cc);
        uint2 pk;
        pk.x = pack2(lo_bf(uu.x) * (acc[i][j][0] + bias), hi_bf(uu.x) * (acc[i][j][1] + bias));
        pk.y = pack2(lo_bf(uu.y) * (acc[i][j][2] + bias), hi_bf(uu.y) * (acc[i][j][3] + bias));
        *(uint2*)(mix + (size_t)(r0 + pp) * 1024 + g * 128 + cc) = pk;
      }
    }
  }
  __syncthreads();
}

__device__ __forceinline__ void attn_item(const Params& p, bool latent, int b, int rq, int h, const bf16_t* __restrict__ pb, bf16_t* __restrict__ mix, char* smem) {
  int tid = threadIdx.x;
  asm volatile("" : "+v"(tid));
  const int lane = tid & 63, wv = tid >> 6, fr = lane & 15, fq = lane >> 4;
  const int qcol = wv * 16 + fr;
  const int qrow = latent ? (b * 4096 + rq * 64 + qcol) : (ROWS_L + b * 256 + rq * 64 + qcol);
  const int nnb = latent ? 8 : 0, nblk = nnb + 4;
  const int row_start = min(max(rq - 4, 0), 56);
  const int col_start = min(max(qcol - 8, 0), 48);
  const int kc0 = min(max(wv * 16 - 8, 0), 32);
  bf16x8 qf[2];
#pragma unroll
  for (int s2 = 0; s2 < 2; ++s2) {
    const uint4 u = *(const uint4*)(pb + (size_t)qrow * NIN0 + 1024 + h * 64 + s2 * 32 + fq * 8);
    uint4 v;
    v.x = pack2(lo_bf(u.x) * 0.125f, hi_bf(u.x) * 0.125f); v.y = pack2(lo_bf(u.y) * 0.125f, hi_bf(u.y) * 0.125f);
    v.z = pack2(lo_bf(u.z) * 0.125f, hi_bf(u.z) * 0.125f); v.w = pack2(lo_bf(u.w) * 0.125f, hi_bf(u.w) * 0.125f);
    qf[s2] = *(bf16x8*)&v;
  }
  f32x4 o[4];
#pragma unroll
  for (int dt = 0; dt < 4; ++dt) o[dt] = (f32x4){0.f, 0.f, 0.f, 0.f};
  float mrow = -1e30f, lsum = 0.f;
  uint4 rk[2], rv[2];
  auto blk_row = [&](int kb) -> int { return (kb < nnb) ? (b * 4096 + (row_start + kb) * 64) : (ROWS_L + b * 256 + (kb - nnb) * 64); };
  auto gload = [&](int kb) {
    const int r0 = blk_row(kb);
#pragma unroll
    for (int i = 0; i < 2; ++i) {
      const int sidx = tid + i * 256, key = sidx & 63, c8 = sidx >> 6;
      const bf16_t* rp = pb + (size_t)(r0 + key) * NIN0 + h * 64 + c8 * 8;
      rk[i] = *(const uint4*)(rp + 1536);
      rv[i] = *(const uint4*)(rp + 2048);
    }
  };
  auto lstore = [&](int buf) {
    bf16_t* kb_ = (bf16_t*)(smem + buf * 18432);
    bf16_t* vt_ = (bf16_t*)(smem + buf * 18432 + 9216);
#pragma unroll
    for (int i = 0; i < 2; ++i) {
      const int sidx = tid + i * 256, key = sidx & 63, c8 = sidx >> 6;
      *(uint4*)(kb_ + key * LDK + c8 * 8) = rk[i];
      bf16_t* dp = vt_ + (c8 * 8) * LDK + key;
      const uint4 u = rv[i];
      dp[0 * LDK] = (bf16_t)(u.x & 0xffff); dp[1 * LDK] = (bf16_t)(u.x >> 16);
      dp[2 * LDK] = (bf16_t)(u.y & 0xffff); dp[3 * LDK] = (bf16_t)(u.y >> 16);
      dp[4 * LDK] = (bf16_t)(u.z & 0xffff); dp[5 * LDK] = (bf16_t)(u.z >> 16);
      dp[6 * LDK] = (bf16_t)(u.w & 0xffff); dp[7 * LDK] = (bf16_t)(u.w >> 16);
    }
  };
  gload(0);
  lstore(0);
  __syncthreads();
  for (int kb = 0; kb < nblk; ++kb) {
    const int buf = kb & 1;
    if (kb + 1 < nblk) gload(kb + 1);
    const bf16_t* kbuf = (const bf16_t*)(smem + buf * 18432);
    const bf16_t* vtb = (const bf16_t*)(smem + buf * 18432 + 9216);
    const bool nb = kb < nnb;
    const int k0 = nb ? kc0 : 0;
    const int ntile = nb ? 2 : 4;
    f32x4 sc[4];
#pragma unroll
    for (int j = 0; j < 4; ++j) sc[j] = (f32x4){0.f, 0.f, 0.f, 0.f};
#pragma unroll
    for (int j = 0; j < 4; ++j) {
      if (j < ntile) {
#pragma unroll
        for (int s2 = 0; s2 < 2; ++s2) {
          const bf16x8 kf = *(const bf16x8*)(kbuf + (k0 + j * 16 + fr) * LDK + s2 * 32 + fq * 8);
          sc[j] = __builtin_amdgcn_mfma_f32_16x16x32_bf16(kf, qf[s2], sc[j], 0, 0, 0);
        }
      }
    }
    float bm = -1e30f;
    if (nb) {
      const int dr = row_start + kb - rq + 7;
      const float* bp = p.ab_rel_bias + (h * 15 + dr) * 31 + 15 - qcol;
#pragma unroll
      for (int j = 0; j < 2; ++j)
#pragma unroll
        for (int r = 0; r < 4; ++r) {
          const int kc = k0 + j * 16 + fq * 4 + r;
          const bool ok = (kc >= col_start) && (kc < col_start + 16);
          const float v = ok ? sc[j][r] + bp[ok ? kc : qcol] : -1e30f;
          sc[j][r] = v;
          bm = fmaxf(bm, v);
        }
    } else {
#pragma unroll
      for (int j = 0; j < 4; ++j)
#pragma unroll
        for (int r = 0; r < 4; ++r) bm = fmaxf(bm, sc[j][r]);
    }
    bm = fmaxf(bm, __shfl_xor(bm, 16));
    bm = fmaxf(bm, __shfl_xor(bm, 32));
    const float mnew = fmaxf(mrow, bm);
    const float corr = __expf(mrow - mnew);
    mrow = mnew;
    float ps = 0.f;
#pragma unroll
    for (int j = 0; j < 4; ++j)
#pragma unroll
      for (int r = 0; r < 4; ++r) {
        const float pe = (j < ntile) ? __expf(sc[j][r] - mnew) : 0.f;
        sc[j][r] = pe;
        ps += pe;
      }
    lsum = lsum * corr + ps;
#pragma unroll
    for (int dt = 0; dt < 4; ++dt) { o[dt][0] *= corr; o[dt][1] *= corr; o[dt][2] *= corr; o[dt][3] *= corr; }
#pragma unroll
    for (int jp = 0; jp < 2; ++jp) {
      if (jp * 2 < ntile) {
        uint4 pk;
        pk.x = pack2(sc[2 * jp][0], sc[2 * jp][1]); pk.y = pack2(sc[2 * jp][2], sc[2 * jp][3]);
        pk.z = pack2(sc[2 * jp + 1][0], sc[2 * jp + 1][1]); pk.w = pack2(sc[2 * jp + 1][2], sc[2 * jp + 1][3]);
        const bf16x8 pf = *(bf16x8*)&pk;
#pragma unroll
        for (int dt = 0; dt < 4; ++dt) {
          const bf16_t* vp = vtb + (dt * 16 + fr) * LDK + k0 + jp * 32 + fq * 4;
          uint4 vv;
          const uint2 lo = *(const uint2*)vp, hi = *(const uint2*)(vp + 16);
          vv.x = lo.x; vv.y = lo.y; vv.z = hi.x; vv.w = hi.y;
          o[dt] = __builtin_amdgcn_mfma_f32_16x16x32_bf16(*(bf16x8*)&vv, pf, o[dt], 0, 0, 0);
        }
      }
    }
    if (kb + 1 < nblk) lstore(buf ^ 1);
    __syncthreads();
  }
  lsum += __shfl_xor(lsum, 16);
  lsum += __shfl_xor(lsum, 32);
  const float inv = 1.f / lsum;
#pragma unroll
  for (int dt = 0; dt < 4; ++dt) {
    uint2 pk; pk.x = pack2(o[dt][0] * inv, o[dt][1] * inv); pk.y = pack2(o[dt][2] * inv, o[dt][3] * inv);
    *(uint2*)(mix + (size_t)qrow * 1024 + 512 + h * 64 + dt * 16 + fq * 4) = pk;
  }
}

__device__ __forceinline__ void phase_mix0(const Params& p, char* smem) {
  const bf16_t* pb = (const bf16_t*)(p.ws + OFF_BIG);
  bf16_t* mix = (bf16_t*)(p.ws + OFF_HM);
  const int n_sgu = 272 * 4, n_al = 8 * 64 * 8, n_ac = 8 * 4 * 8;
  const int total = n_sgu + n_al + n_ac;
  for (int it = blockIdx.x; it < total; it += gridDim.x) {
    if (it < n_al) { int t = it; attn_item(p, true, t >> 9, (t >> 3) & 63, t & 7, pb, mix, smem); }
    else if (it < n_al + n_ac) { int t = it - n_al; attn_item(p, false, t >> 5, (t >> 3) & 3, t & 7, pb, mix, smem); }
    else { int t = it - n_al - n_ac; sgu_item(p, t >> 2, t & 3, pb, mix, smem); }
  }
}


constexpr size_t OFF_DEC = OFF_BIG + 177 * MiB;
template <int NJ>
__device__ __forceinline__ void wave_mma_lds(const bf16_t* A, const bf16_t* Bt, f32x4 (&acc)[NJ], int fr, int fq) {
#pragma unroll
  for (int s = 0; s < 2; ++s) {
    const bf16x8 a = *(const bf16x8*)(A + fr * LDK + s * 32 + fq * 8);
#pragma unroll
    for (int j = 0; j < NJ; ++j) {
      const bf16x8 b = *(const bf16x8*)(Bt + (j * 16 + fr) * LDK + s * 32 + fq * 8);
      acc[j] = __builtin_amdgcn_mfma_f32_16x16x32_bf16(b, a, acc[j], 0, 0, 0);
    }
  }
}
template <int NJ>
__device__ __forceinline__ void wave_mma_glb(const bf16_t* A, const bf16_t* Btg, f32x4 (&acc)[NJ], int fr, int fq) {
#pragma unroll
  for (int s = 0; s < 2; ++s) {
    const bf16x8 a = *(const bf16x8*)(A + fr * LDK + s * 32 + fq * 8);
#pragma unroll
    for (int j = 0; j < NJ; ++j) {
      const bf16x8 b = *(const bf16x8*)(Btg + (j * 16 + fr) * 64 + s * 32 + fq * 8);
      acc[j] = __builtin_amdgcn_mfma_f32_16x16x32_bf16(b, a, acc[j], 0, 0, 0);
    }
  }
}

template <bool LATENT, bool WANT_OUT, bool WANT_KV>
__device__ __forceinline__ void gla_prep(const Params& p, const bf16_t* __restrict__ pb, int rbase, int h, int dir, int n, char* smem, float* decay_out) {
  bf16_t* kraw = (bf16_t*)smem;
  bf16_t* qraw = (bf16_t*)(smem + 8192);
  float* tot = (float*)(smem + 16384);
  bf16_t* qe = (bf16_t*)(smem + 17408);
  bf16_t* kinv = (bf16_t*)(smem + 26624);
  bf16_t* kdecT = (bf16_t*)(smem + 35840);
  const float* tab = (const float*)(p.ws + OFF_TAB);
  int tid = threadIdx.x;
  asm volatile("" : "+v"(tid));
  const int d = tid & 63, lq = tid >> 6;
#pragma unroll
  for (int i = 0; i < 2; ++i) {
    const int idx = tid + i * 256, l = idx >> 3, c8 = idx & 7;
    const bf16_t* rp = pb + (size_t)(rbase + l) * NIN1P + h * 64 + c8 * 8;
    *(uint4*)(kraw + l * 64 + c8 * 8) = *(const uint4*)(rp + 768);
    if (WANT_OUT) *(uint4*)(qraw + l * 64 + c8 * 8) = *(const uint4*)(rp + 512);
  }
  bf16_t* araw = (bf16_t*)(smem + 63488);
  if (tid < 128) {
    const int l = tid >> 1, hf = tid & 1;
    *(uint4*)(araw + l * 16 + hf * 8) = *(const uint4*)(pb + (size_t)(rbase + l) * NIN1P + 2048 + dir * 16 + hf * 8);
  }
  const float* dw = dir ? p.cd_dw_b : p.cd_dw_f;
  const float* db = dir ? p.cd_db_b : p.cd_db_f;
  float w[16];
#pragma unroll
  for (int j = 0; j < 16; ++j) w[j] = dw[j * 256 + h * 64 + d];
  const float bias = db[h * 64 + d];
  float c[16];
  __syncthreads();
#pragma unroll
  for (int i = 0; i < 16; ++i) {
    const bf16_t* ap = araw + (lq * 16 + i) * 16;
    const uint4 u0 = *(const uint4*)ap, u1 = *(const uint4*)(ap + 8);
    float x = bias;
    x += lo_bf(u0.x) * w[0] + hi_bf(u0.x) * w[1] + lo_bf(u0.y) * w[2] + hi_bf(u0.y) * w[3];
    x += lo_bf(u0.z) * w[4] + hi_bf(u0.z) * w[5] + lo_bf(u0.w) * w[6] + hi_bf(u0.w) * w[7];
    x += lo_bf(u1.x) * w[8] + hi_bf(u1.x) * w[9] + lo_bf(u1.y) * w[10] + hi_bf(u1.y) * w[11];
    x += lo_bf(u1.z) * w[12] + hi_bf(u1.z) * w[13] + lo_bf(u1.w) * w[14] + hi_bf(u1.w) * w[15];
    c[i] = (fminf(x, 0.f) - __logf(1.f + __expf(-fabsf(x)))) * (1.f / 16.f);
    __builtin_amdgcn_sched_barrier(0);
  }
  if (dir == 0) {
#pragma unroll
    for (int i = 1; i < 16; ++i) c[i] += c[i - 1];
    tot[lq * 64 + d] = c[15];
  } else {
#pragma unroll
    for (int i = 14; i >= 0; --i) c[i] += c[i + 1];
    tot[lq * 64 + d] = c[0];
  }
  __syncthreads();
  const float t0 = tot[d], t1 = tot[64 + d], t2 = tot[128 + d], t3 = tot[192 + d];
  const float ctot = (t0 + t1) + (t2 + t3);
  float off;
  if (dir == 0) off = (lq > 0 ? t0 : 0.f) + (lq > 1 ? t1 : 0.f) + (lq > 2 ? t2 : 0.f);
  else off = (lq < 3 ? t3 : 0.f) + (lq < 2 ? t2 : 0.f) + (lq < 1 ? t1 : 0.f);
  float kd_prev = 0.f;
#pragma unroll
  for (int i = 0; i < 16; ++i) {
    const int l = lq * 16 + i;
    const float cc = c[i] + off;
    float kv = bf2f(kraw[l * 64 + d]);
    float qv = WANT_OUT ? bf2f(qraw[l * 64 + d]) : 0.f;
    if (LATENT) {
      const float kp = bf2f(kraw[l * 64 + (d ^ 16)]);
      const int pos = (d < 32) ? n : l;
      const float cs = tab[8576 + pos * 16 + (d & 15)], sn = tab[9600 + pos * 16 + (d & 15)];
      const float sg = (d & 16) ? sn : -sn;
      kv = kv * cs + kp * sg;
      if (WANT_OUT) { const float qp = bf2f(qraw[l * 64 + (d ^ 16)]); qv = qv * cs + qp * sg; }
    }
    if (WANT_OUT) {
      qe[l * LDK + d] = f2bf(qv * 0.125f * __expf(cc));
      kinv[l * LDK + d] = f2bf(kv * __expf(-cc));
    }
    if (WANT_KV) {
      const float kd = kv * __expf(ctot - cc);
      if (i & 1) *(unsigned*)(kdecT + d * LDK + l - 1) = pack2(kd_prev, kd);
      kd_prev = kd;
    }
    __builtin_amdgcn_sched_barrier(0);
  }
  if (WANT_KV && lq == 0) decay_out[d] = __expf(ctot);
}

__device__ __forceinline__ void gla_stage_vT(const bf16_t* __restrict__ pb, int rbase, int h, char* smem) {
  bf16_t* vT = (bf16_t*)(smem + 45056);
  const int tid = threadIdx.x;
#pragma unroll
  for (int i = 0; i < 4; ++i) {
    const int idx = tid + i * 256, l = idx & 63, e8 = idx >> 6;
    const uint4 u = *(const uint4*)(pb + (size_t)(rbase + l) * NIN1P + 1024 + h * 128 + e8 * 8);
    bf16_t* dp = vT + (e8 * 8) * LDK + l;
    dp[0 * LDK] = (bf16_t)(u.x & 0xffff); dp[1 * LDK] = (bf16_t)(u.x >> 16);
    dp[2 * LDK] = (bf16_t)(u.y & 0xffff); dp[3 * LDK] = (bf16_t)(u.y >> 16);
    dp[4 * LDK] = (bf16_t)(u.z & 0xffff); dp[5 * LDK] = (bf16_t)(u.z >> 16);
    dp[6 * LDK] = (bf16_t)(u.w & 0xffff); dp[7 * LDK] = (bf16_t)(u.w >> 16);
  }
}

__device__ __forceinline__ void gla_kv_item(const Params& p, int b, int h, int dir, int j, const bf16_t* __restrict__ pb, char* smem) {
  const int sidx = ((b * 4 + h) * 2 + dir) * 68 + j;
  bf16_t* slot = (bf16_t*)(p.ws + OFF_EXTRA) + (size_t)sidx * 8192;
  float* dec = (float*)(p.ws + OFF_DEC) + (size_t)sidx * 64;
  int rbase;
  if (j < 4) {
    const int nc = dir ? 3 - j : j;
    rbase = ROWS_L + b * 256 + nc * 64;
    gla_prep<false, false, true>(p, pb, rbase, h, dir, 0, smem, dec);
  } else {
    const int jj = j - 4, n = dir ? 63 - jj : jj;
    rbase = b * 4096 + n * 64;
    gla_prep<true, false, true>(p, pb, rbase, h, dir, n, smem, dec);
  }
  gla_stage_vT(pb, rbase, h, smem);
  __syncthreads();
  const bf16_t* kdecT = (const bf16_t*)(smem + 35840);
  const bf16_t* vT = (const bf16_t*)(smem + 45056);
  const int lane = threadIdx.x & 63, wv = threadIdx.x >> 6, fr = lane & 15, fq = lane >> 4;
#pragma unroll
  for (int i2 = 0; i2 < 2; ++i2) {
    f32x4 acc[4];
#pragma unroll
    for (int jn = 0; jn < 4; ++jn) acc[jn] = (f32x4){0.f, 0.f, 0.f, 0.f};
    wave_mma_lds<4>(vT + (wv * 32 + i2 * 16) * LDK, kdecT, acc, fr, fq);
    const int e = wv * 32 + i2 * 16 + fr;
#pragma unroll
    for (int jn = 0; jn < 4; ++jn) {
      uint2 pk; pk.x = pack2(acc[jn][0], acc[jn][1]); pk.y = pack2(acc[jn][2], acc[jn][3]);
      *(uint2*)(slot + e * 64 + jn * 16 + fq * 4) = pk;
    }
  }
  __syncthreads();
}

__device__ __forceinline__ void gla_scan_item(const Params& p, int bhd, int es) {
  const int tid = threadIdx.x, e = es * 32 + (tid >> 3), d0 = (tid & 7) * 8;
  bf16_t* base = (bf16_t*)(p.ws + OFF_EXTRA) + (size_t)bhd * 68 * 8192 + e * 64 + d0;
  const float* dec = (const float*)(p.ws + OFF_DEC) + (size_t)bhd * 68 * 64 + d0;
  float s[8];
#pragma unroll
  for (int k = 0; k < 8; ++k) s[k] = 0.f;
#pragma unroll 4
  for (int j = 0; j < 68; ++j) {
    const uint4 u = *(const uint4*)(base + (size_t)j * 8192);
    const float4 da = *(const float4*)(dec + j * 64), dbb = *(const float4*)(dec + j * 64 + 4);
#ifndef SCAN_NOSTORE
    if (j >= 4) {
      uint4 o; o.x = pack2(s[0], s[1]); o.y = pack2(s[2], s[3]); o.z = pack2(s[4], s[5]); o.w = pack2(s[6], s[7]);
      *(uint4*)(base + (size_t)j * 8192) = o;
    }
#endif
    s[0] = da.x * s[0] + lo_bf(u.x); s[1] = da.y * s[1] + hi_bf(u.x); s[2] = da.z * s[2] + lo_bf(u.y); s[3] = da.w * s[3] + hi_bf(u.y);
    s[4] = dbb.x * s[4] + lo_bf(u.z); s[5] = dbb.y * s[5] + hi_bf(u.z); s[6] = dbb.z * s[6] + lo_bf(u.w); s[7] = dbb.w * s[7] + hi_bf(u.w);
  }
#ifdef SCAN_NOSTORE
  { float* o = p.out + ((size_t)bhd * 128 + e) * 64 + d0;
#pragma unroll
    for (int k = 0; k < 8; ++k) o[k] = s[k]; }
#endif
}

__device__ __forceinline__ void gla_out_item(const Params& p, int b, int h, int n, const bf16_t* __restrict__ pb, bf16_t* __restrict__ mix, char* smem) {
  const int rbase = b * 4096 + n * 64;
  const bf16_t* qe = (const bf16_t*)(smem + 17408);
  const bf16_t* kinv = (const bf16_t*)(smem + 26624);
  bf16_t* att = (bf16_t*)(smem + 35840);
  const bf16_t* vT = (const bf16_t*)(smem + 45056);
  int tid_ = threadIdx.x;
  asm volatile("" : "+v"(tid_));
  const int lane = tid_ & 63, wv = tid_ >> 6, fr = lane & 15, fq = lane >> 4;
  f32x4 o[8];
#pragma unroll
  for (int jn = 0; jn < 8; ++jn) o[jn] = (f32x4){0.f, 0.f, 0.f, 0.f};
  gla_stage_vT(pb, rbase, h, smem);
#pragma unroll 1
  for (int dir = 0; dir < 2; ++dir) {
    gla_prep<true, true, false>(p, pb, rbase, h, dir, n, smem, nullptr);
    __syncthreads();
    f32x4 a4[4];
#pragma unroll
    for (int jn = 0; jn < 4; ++jn) a4[jn] = (f32x4){0.f, 0.f, 0.f, 0.f};
    wave_mma_lds<4>(qe + wv * 16 * LDK, kinv, a4, fr, fq);
    const int row = wv * 16 + fr;
#pragma unroll
    for (int jn = 0; jn < 4; ++jn) {
      float v[4];
#pragma unroll
      for (int r = 0; r < 4; ++r) {
        const int col = jn * 16 + fq * 4 + r;
        const bool keep = dir ? (col >= row) : (col <= row);
        v[r] = keep ? a4[jn][r] : 0.f;
      }
      uint2 pk; pk.x = pack2(v[0], v[1]); pk.y = pack2(v[2], v[3]);
      *(uint2*)(att + row * LDK + jn * 16 + fq * 4) = pk;
    }
    __syncthreads();
    wave_mma_lds<8>(att + wv * 16 * LDK, vT, o, fr, fq);
    const int jj = dir ? 63 - n : n;
    const bf16_t* ST = (const bf16_t*)(p.ws + OFF_EXTRA) + (size_t)(((b * 4 + h) * 2 + dir) * 68 + 4 + jj) * 8192;
    wave_mma_glb<8>(qe + wv * 16 * LDK, ST, o, fr, fq);
    __syncthreads();
  }
  float ss = 0.f;
#pragma unroll
  for (int jn = 0; jn < 8; ++jn) ss += o[jn][0] * o[jn][0] + o[jn][1] * o[jn][1] + o[jn][2] * o[jn][2] + o[jn][3] * o[jn][3];
  ss += __shfl_xor(ss, 16);
  ss += __shfl_xor(ss, 32);
  const float rstd = rsqrtf(ss * (1.f / 128.f) + 1e-6f);
  const int trow = rbase + wv * 16 + fr;
#pragma unroll
  for (int jn = 0; jn < 8; ++jn) {
    const int e = jn * 16 + fq * 4;
    const uint2 gq = *(const uint2*)(pb + (size_t)trow * NIN1P + 1536 + h * 128 + e);
    const float4 hw = *(const float4*)(p.cd_head_norm_w + e);
    const float y0 = o[jn][0] * rstd * hw.x * siluf_(lo_bf(gq.x)), y1 = o[jn][1] * rstd * hw.y * siluf_(hi_bf(gq.x));
    const float y2 = o[jn][2] * rstd * hw.z * siluf_(lo_bf(gq.y)), y3 = o[jn][3] * rstd * hw.w * siluf_(hi_bf(gq.y));
    uint2 pk; pk.x = pack2(y0, y1); pk.y = pack2(y2, y3);
    *(uint2*)(mix + (size_t)trow * 1024 + 512 + h * 128 + e) = pk;
  }
}

__device__ __forceinline__ void fft1_item(const Params& p, int b, int g, int t2, const bf16_t* __restrict__ pb, char* smem) {
  bf16_t* GT = (bf16_t*)smem;
  const bf16_t* T1 = (const bf16_t*)(p.ws + OFF_TAB + 65536);
  const bf16_t* C64 = T1 + 32768;
  const bf16_t* S64 = C64 + 4096;
  const bf16_t* NS64 = C64 + 8192;
  const float* tab = (const float*)(p.ws + OFF_TAB);
  int tid = threadIdx.x;
  asm volatile("" : "+v"(tid));
  const int lane = tid & 63, wv = tid >> 6, fr = lane & 15, fq = lane >> 4;
  {
    f32x4 ga[16];
#pragma unroll
    for (int j = 0; j < 16; ++j) ga[j] = (f32x4){0.f, 0.f, 0.f, 0.f};
    const bf16_t* frow = pb + (size_t)(b * 4096 + (wv * 16 + fr) * 64 + t2) * NIN1P + g * 128 + fq * 8;
#pragma unroll
    for (int s4 = 0; s4 < 4; ++s4) {
      const bf16x8 af = *(const bf16x8*)(frow + s4 * 32);
#pragma unroll
      for (int j = 0; j < 16; ++j) {
        const bf16x8 bfr = *(const bf16x8*)(T1 + (j * 16 + fr) * 128 + s4 * 32 + fq * 8);
        ga[j] = __builtin_amdgcn_mfma_f32_16x16x32_bf16(bfr, af, ga[j], 0, 0, 0);
      }
    }
#pragma unroll
    for (int j = 0; j < 16; ++j)
#pragma unroll
      for (int r = 0; r < 4; ++r) GT[(j * 16 + fq * 4 + r) * LDK + wv * 16 + fr] = f2bf(ga[j][r]);
  }
  __syncthreads();
  {
    f32x4 ar[8], ai[8];
#pragma unroll
    for (int j = 0; j < 8; ++j) { ar[j] = (f32x4){0.f, 0.f, 0.f, 0.f}; ai[j] = (f32x4){0.f, 0.f, 0.f, 0.f}; }
    const int k1 = wv * 16 + fr;
#pragma unroll
    for (int s2 = 0; s2 < 2; ++s2) {
      const bf16x8 cf = *(const bf16x8*)(C64 + k1 * 64 + s2 * 32 + fq * 8);
      const bf16x8 sf = *(const bf16x8*)(S64 + k1 * 64 + s2 * 32 + fq * 8);
      const bf16x8 nsf = *(const bf16x8*)(NS64 + k1 * 64 + s2 * 32 + fq * 8);
#pragma unroll
      for (int j = 0; j < 8; ++j) {
        const bf16x8 grf = *(const bf16x8*)(GT + (j * 16 + fr) * LDK + s2 * 32 + fq * 8);
        const bf16x8 gif = *(const bf16x8*)(GT + (128 + j * 16 + fr) * LDK + s2 * 32 + fq * 8);
        ar[j] = __builtin_amdgcn_mfma_f32_16x16x32_bf16(grf, cf, ar[j], 0, 0, 0);
        ar[j] = __builtin_amdgcn_mfma_f32_16x16x32_bf16(gif, sf, ar[j], 0, 0, 0);
        ai[j] = __builtin_amdgcn_mfma_f32_16x16x32_bf16(gif, cf, ai[j], 0, 0, 0);
        ai[j] = __builtin_amdgcn_mfma_f32_16x16x32_bf16(grf, nsf, ai[j], 0, 0, 0);
      }
    }
    const int tw = k1 * t2;
    const float tc = tab[384 + tw], ts = tab[4480 + tw];
    bf16_t* apr = (bf16_t*)p.out + ((size_t)((b * 4 + g) * 64 + k1) * 64 + t2) * 128;
    bf16_t* api = apr + 16777216;
#pragma unroll
    for (int j = 0; j < 8; ++j) {
      uint2 pr, pi;
      pr.x = pack2(ar[j][0] * tc + ai[j][0] * ts, ar[j][1] * tc + ai[j][1] * ts);
      pr.y = pack2(ar[j][2] * tc + ai[j][2] * ts, ar[j][3] * tc + ai[j][3] * ts);
      pi.x = pack2(ai[j][0] * tc - ar[j][0] * ts, ai[j][1] * tc - ar[j][1] * ts);
      pi.y = pack2(ai[j][2] * tc - ar[j][2] * ts, ai[j][3] * tc - ar[j][3] * ts);
      *(uint2*)(apr + j * 16 + fq * 4) = pr;
      *(uint2*)(api + j * 16 + fq * 4) = pi;
    }
  }
  __syncthreads();
}

__device__ __forceinline__ void fft2_item(const Params& p, int b, int g, int k1, bf16_t* __restrict__ mix, char* smem) {
  bf16_t* ArT = (bf16_t*)smem;
  bf16_t* AiT = ArT + 128 * LDK;
  const bf16_t* C64 = (const bf16_t*)(p.ws + OFF_TAB + 65536) + 32768;
  const bf16_t* S64 = C64 + 4096;
  const bf16_t* apr = (const bf16_t*)p.out + (size_t)((b * 4 + g) * 64 + k1) * 64 * 128;
  const bf16_t* api = apr + 16777216;
  int tid = threadIdx.x;
  asm volatile("" : "+v"(tid));
#pragma unroll
  for (int i = 0; i < 4; ++i) {
    const int idx = tid + i * 256, t2 = idx & 63, m8 = idx >> 6;
    const uint4 u = *(const uint4*)(apr + t2 * 128 + m8 * 8);
    const uint4 v = *(const uint4*)(api + t2 * 128 + m8 * 8);
    bf16_t* dr = ArT + (m8 * 8) * LDK + t2;
    bf16_t* di = AiT + (m8 * 8) * LDK + t2;
    dr[0 * LDK] = (bf16_t)(u.x & 0xffff); dr[1 * LDK] = (bf16_t)(u.x >> 16); dr[2 * LDK] = (bf16_t)(u.y & 0xffff); dr[3 * LDK] = (bf16_t)(u.y >> 16);
    dr[4 * LDK] = (bf16_t)(u.z & 0xffff); dr[5 * LDK] = (bf16_t)(u.z >> 16); dr[6 * LDK] = (bf16_t)(u.w & 0xffff); dr[7 * LDK] = (bf16_t)(u.w >> 16);
    di[0 * LDK] = (bf16_t)(v.x & 0xffff); di[1 * LDK] = (bf16_t)(v.x >> 16); di[2 * LDK] = (bf16_t)(v.y & 0xffff); di[3 * LDK] = (bf16_t)(v.y >> 16);
    di[4 * LDK] = (bf16_t)(v.z & 0xffff); di[5 * LDK] = (bf16_t)(v.z >> 16); di[6 * LDK] = (bf16_t)(v.w & 0xffff); di[7 * LDK] = (bf16_t)(v.w >> 16);
  }
  __syncthreads();
  const int lane = tid & 63, wv = tid >> 6, fr = lane & 15, fq = lane >> 4;
  const int k2 = wv * 16 + fr;
  f32x4 x[8];
#pragma unroll
  for (int j = 0; j < 8; ++j) x[j] = (f32x4){0.f, 0.f, 0.f, 0.f};
#pragma unroll
  for (int s2 = 0; s2 < 2; ++s2) {
    const bf16x8 cf = *(const bf16x8*)(C64 + k2 * 64 + s2 * 32 + fq * 8);
    const bf16x8 sf = *(const bf16x8*)(S64 + k2 * 64 + s2 * 32 + fq * 8);
#pragma unroll
    for (int j = 0; j < 8; ++j) {
      const bf16x8 rf = *(const bf16x8*)(ArT + (j * 16 + fr) * LDK + s2 * 32 + fq * 8);
      const bf16x8 jf = *(const bf16x8*)(AiT + (j * 16 + fr) * LDK + s2 * 32 + fq * 8);
      x[j] = __builtin_amdgcn_mfma_f32_16x16x32_bf16(rf, cf, x[j], 0, 0, 0);
      x[j] = __builtin_amdgcn_mfma_f32_16x16x32_bf16(jf, sf, x[j], 0, 0, 0);
    }
  }
  const float scale = 0.0013810679320049757f;
  bf16_t* orow = mix + (size_t)(b * 4096 + k1 + 64 * k2) * 1024 + g * 128;
#pragma unroll
  for (int j = 0; j < 8; ++j) {
    uint2 pk; pk.x = pack2(x[j][0] * scale, x[j][1] * scale); pk.y = pack2(x[j][2] * scale, x[j][3] * scale);
    *(uint2*)(orow + j * 16 + fq * 4) = pk;
  }
  __syncthreads();
}

__device__ __forceinline__ void phase_mix1a(const Params& p, char* smem) {
  const bf16_t* pb = (const bf16_t*)(p.ws + OFF_BIG);
  const int n_kv = 64 * 68, n_f1 = 8 * 4 * 64;
  for (int it = blockIdx.x; it < n_kv + n_f1; it += gridDim.x) {
    if (it < n_kv) { const int bhd = it / 68, j = it % 68; gla_kv_item(p, bhd >> 3, (bhd >> 1) & 3, bhd & 1, j, pb, smem); }
    else { int t = it - n_kv; fft1_item(p, t >> 8, (t >> 6) & 3, t & 63, pb, smem); }
  }
}

__device__ __forceinline__ void phase_mix1b(const Params& p, char* smem) {
  bf16_t* mix = (bf16_t*)(p.ws + OFF_HM);
  const int n_scan = 256, n_f2 = 8 * 4 * 64;
  for (int it = blockIdx.x; it < n_scan + n_f2; it += gridDim.x) {
#ifndef NO_SCAN
    if (it < n_scan) gla_scan_item(p, it >> 2, it & 3); else
#endif
    { int t = it - n_scan; if (t >= 0) fft2_item(p, t >> 8, (t >> 6) & 3, t & 63, mix, smem); }
  }
}

__device__ __forceinline__ void phase_mix1c(const Params& p, char* smem) {
  const bf16_t* pb = (const bf16_t*)(p.ws + OFF_BIG);
  bf16_t* mix = (bf16_t*)(p.ws + OFF_HM);
  for (int it = blockIdx.x; it < 2048; it += gridDim.x) gla_out_item(p, it >> 8, (it >> 6) & 3, it & 63, pb, mix, smem);
}

#ifndef STOP_AFTER
#define STOP_AFTER 107
#define DUMP_OB 1.0f
#define DUMP_AP 0.0f
#endif
__device__ __forceinline__ void dump_bf16(const bf16_t* buf, int ld, int ncols, float* out) {
  for (size_t idx = (size_t)blockIdx.x * NT + threadIdx.x; idx < (size_t)ROWS_L * 1024; idx += (size_t)gridDim.x * NT) {
    const int r = (int)(idx >> 10), c = (int)(idx & 1023);
    float s = 0.f;
    for (int cc = c; cc < ncols; cc += 1024) {
      s += bf2f(buf[(size_t)r * ld + cc]);
      if (r < ROWS_C) s += bf2f(buf[(size_t)(r + ROWS_L) * ld + cc]);
    }
    out[idx] = s;
  }
}
__device__ __forceinline__ void dump_f32(const float* buf, float* out) {
  for (size_t idx = (size_t)blockIdx.x * NT + threadIdx.x; idx < (size_t)ROWS_L * 1024; idx += (size_t)gridDim.x * NT) {
    const int r = (int)(idx >> 10);
    float s = buf[idx];
    if (r < ROWS_C) s += buf[idx + (size_t)ROWS_L * 1024];
    out[idx] = s;
  }
}

#define XB_XCNT(j) (256 + 64 * (j))
#define XB_XSUB(j) (1280 + 64 * (j))
#define XB_XGEN(j) (2304 + 64 * (j))
#define XB_TOP 3328
#define XB_TOPGEN 3392
struct BarState { unsigned x, nloc, nx; };
__device__ __forceinline__ unsigned xb_ld(unsigned* p) { return __hip_atomic_load(p, __ATOMIC_RELAXED, __HIP_MEMORY_SCOPE_AGENT); }
__device__ __forceinline__ unsigned xb_add(unsigned* p, unsigned v) { return __hip_atomic_fetch_add(p, v, __ATOMIC_RELAXED, __HIP_MEMORY_SCOPE_AGENT); }
__device__ __forceinline__ void grid_barrier_post(unsigned* bar, BarState& st) {
  st.x = (unsigned)__builtin_amdgcn_s_getreg((3 << 11) | 20) & 0xFu;
  st.nloc = 0u; st.nx = 0u;
  if (threadIdx.x == 0) (void)xb_add(&bar[XB_XCNT(st.x)], 1u);
}
__device__ __forceinline__ void grid_barrier(unsigned* bar, BarState& st, const float*, float*) {
  asm volatile("s_waitcnt vmcnt(0) lgkmcnt(0)" ::: "memory");
  __syncthreads();
  if (threadIdx.x == 0) {
    if (st.nloc == 0u) {
      const unsigned G = gridDim.x;
      for (;;) {
        unsigned sum = 0u, cnt = 0u, mine = 0u;
#pragma unroll
        for (unsigned j = 0; j < 16; ++j) { const unsigned c = xb_ld(&bar[XB_XCNT(j)]); sum += c; cnt += (c > 0u) ? 1u : 0u; mine = (j == st.x) ? c : mine; }
        if (sum == G) { st.nloc = mine; st.nx = cnt; break; }
        __builtin_amdgcn_s_sleep(1);
      }
    }
    const unsigned old = xb_add(&bar[XB_XSUB(st.x)], 1u);
    const unsigned gen = old / st.nloc;
    if (old + 1u == (gen + 1u) * st.nloc) {
      __builtin_amdgcn_fence(__ATOMIC_RELEASE, "agent");
      asm volatile("s_waitcnt vmcnt(0)" ::: "memory");
      const unsigned og = xb_add(&bar[XB_TOP], 1u);
      const unsigned tg = og / st.nx;
      if (og + 1u == (tg + 1u) * st.nx) (void)xb_add(&bar[XB_TOPGEN], 1u);
      else while (xb_ld(&bar[XB_TOPGEN]) == tg) __builtin_amdgcn_s_sleep(1);
      __builtin_amdgcn_fence(__ATOMIC_ACQUIRE, "agent");
      (void)xb_add(&bar[XB_XGEN(st.x)], 1u);
      asm volatile("s_waitcnt vmcnt(0)" ::: "memory");
    } else {
      while (xb_ld(&bar[XB_XGEN(st.x)]) == gen) __builtin_amdgcn_s_sleep(1);
      __builtin_amdgcn_fence(__ATOMIC_ACQUIRE, "agent");
      asm volatile("s_waitcnt vmcnt(0)" ::: "memory");
    }
  }
  __syncthreads();
}

constexpr int NPHASE = 16;
#ifndef ONLY
#define ONLY -1
#endif
#define PH_EN(n) (ONLY < 0 || ONLY == (n))

template <int PH>
__device__ __forceinline__ void run_phase(const Params& p, char* smem) {
  const float* mod0 = (const float*)(p.ws + OFF_MOD);
  const float* mod1 = mod0 + 9 * MODN;
  float* xres = (float*)(p.ws + OFF_XRES);
  float* xctx = xres + (size_t)ROWS_L * 1024;
  bf16_t* hm = (bf16_t*)(p.ws + OFF_HM);
  bf16_t* big = (bf16_t*)(p.ws + OFF_BIG);
  if (PH == 0) phase_prep(p, smem);
  if (PH == 1) phase_norm(p.x, p.ctx, p.norm_mix_w, mod0, 0, 1024, hm, ROWS);
  if (PH == 2) { Epi e{}; e.C = big; e.ldc = NIN0; e.gelu_cols = 1024;
    gemm_phase<0>(hm, 1024, (const bf16_t*)(p.ws + OFF_WIN0), 1024, ROWS, NIN0, smem, e); }
  if (PH == 3) phase_mix0(p, smem);
  if (PH == 4) { Epi e{}; e.src_lat = p.x; e.src_ctx = p.ctx; e.dst = xres; e.gate = mod0 + 2048;
    gemm_phase<1>(hm, 1024, (const bf16_t*)(p.ws + OFF_WOUT0), 1024, ROWS, 1024, smem, e); }
  if (PH == 5) phase_norm(xres, xctx, p.norm_ffn_w, mod0, 3072, 4096, hm, ROWS);
  if (PH == 6) { Epi e{}; e.C = big; e.ldc = FFN;
    gemm_phase<2>(hm, 1024, (const bf16_t*)(p.ws + OFF_WGU0), 1024, ROWS, 2 * FFN, smem, e); }
  if (PH == 7) { Epi e{}; e.src_lat = xres; e.src_ctx = xctx; e.dst = xres; e.gate = mod0 + 5120;
    gemm_phase<1>(big, FFN, (const bf16_t*)(p.ws + OFF_WD0), FFN, ROWS, 1024, smem, e); }
  if (PH == 8) phase_norm(xres, xctx, p.norm_mix_w + 1024, mod1, 0, 1024, hm, ROWS);
  if (PH == 9) { Epi e{}; e.C = big; e.ldc = NIN1P; e.gelu_cols = 0;
    gemm_phase<0>(hm, 1024, (const bf16_t*)(p.ws + OFF_WIN1), 1024, ROWS, NIN1P, smem, e); }
  if (PH == 10) phase_mix1a(p, smem);
  if (PH == 11) phase_mix1b(p, smem);
  if (PH == 12) phase_mix1c(p, smem);
  if (PH == 13) { Epi e{}; e.src_lat = xres; e.src_ctx = xctx; e.dst = xres; e.gate = mod1 + 2048;
    gemm_phase<1>(hm, 1024, (const bf16_t*)(p.ws + OFF_WOUT1), 1024, ROWS_L, 1024, smem, e); }
  if (PH == 14) phase_norm(xres, xctx, p.norm_ffn_w + 1024, mod1, 3072, 4096, hm, ROWS_L);
  if (PH == 15) { Epi e{}; e.C = big; e.ldc = FFN;
    gemm_phase<2>(hm, 1024, (const bf16_t*)(p.ws + OFF_WGU1), 1024, ROWS_L, 2 * FFN, smem, e); }
  if (PH == 16) { Epi e{}; e.src_lat = xres; e.src_ctx = xctx; e.dst = xres; e.gate = mod1 + 5120;
    gemm_phase<1>(big, FFN, (const bf16_t*)(p.ws + OFF_WD1), FFN, ROWS_L, 1024, smem, e); }
  if (PH == 17) phase_final_norm(xres, p.final_norm_w, p.out);
}
constexpr int NPH = 18;

#ifndef MULTI_LAUNCH
#define MULTI_LAUNCH 0
#endif

#if MULTI_LAUNCH
template <int PH>
__global__ void __launch_bounds__(NT, 2) phase_kernel(Params p) {
  __shared__ __attribute__((aligned(16))) char smem[65536];
  run_phase<PH>(p, smem);
}
template <int PH>
static void launch_phases(const Params& p, int grid, hipStream_t stream) {
  phase_kernel<PH><<<dim3(grid), dim3(NT), 0, stream>>>(p);
  if constexpr (PH + 1 < NPH) launch_phases<PH + 1>(p, grid, stream);
}
#else
template <int PH>
__device__ __forceinline__ void run_all(const Params& p, char* smem, unsigned* bar, BarState& gen) {
  run_phase<PH>(p, smem);
#ifdef DOUBLE_MASK
  if constexpr ((DOUBLE_MASK >> PH) & 1) { grid_barrier(bar, gen, p.x, p.out); run_phase<PH>(p, smem); }
#endif
  if constexpr (PH + 1 < NPH) { grid_barrier(bar, gen, p.x, p.out); run_all<PH + 1>(p, smem, bar, gen); }
}
__global__ void __launch_bounds__(NT, 2) fwd_kernel(Params p) {
  __shared__ __attribute__((aligned(16))) char smem[65536];
  unsigned* bar = (unsigned*)(p.ws + OFF_BAR);
  BarState gen;
  grid_barrier_post(bar, gen);
  run_all<0>(p, smem, bar, gen);
}
#endif

extern "C" void kernel_launch(void* const* d_in, const int* in_sizes, int n_in, void* d_out, int out_size, void* d_ws, size_t ws_size,
                              hipStream_t stream) {
  if (ws_size < WS_NEED) { fprintf(stderr, "workspace too small: %zu\n", ws_size); return; }
  Params p{};
  const float** pp = (const float**)&p;
  for (int i = 0; i < 25; ++i) pp[i] = (const float*)d_in[i];
  p.out = (float*)d_out;
  p.ws = (char*)d_ws;
#if MULTI_LAUNCH
  launch_phases<0>(p, 512, stream);
#else
  static int grid_blocks = 0;
  if (!grid_blocks) {
    int dev = 0, cus = 0, per_cu = 0;
    (void)hipGetDevice(&dev);
    (void)hipDeviceGetAttribute(&cus, hipDeviceAttributeMultiprocessorCount, dev);
    (void)hipOccupancyMaxActiveBlocksPerMultiprocessor(&per_cu, fwd_kernel, NT, 0);
    if (per_cu > 2) per_cu = 2;
    if (per_cu < 1) per_cu = 1;
    grid_blocks = cus * per_cu;
  }
  (void)hipMemsetAsync((char*)d_ws + OFF_BAR, 0, 16384, stream);
  void* args[] = {&p};
  hipError_t err = hipLaunchCooperativeKernel((void*)fwd_kernel, dim3(grid_blocks), dim3(NT), args, 0, stream);
  if (err != hipSuccess) fprintf(stderr, "cooperative launch failed: %s (grid %d)\n", hipGetErrorString(err), grid_blocks);
#endif
}
```

```cpp
#include <hip/hip_runtime.h>
#include <hip/hip_cooperative_groups.h>
#include <cstdio>
namespace cg = cooperative_groups;

typedef unsigned short bf16_t;
typedef short bf16x8 __attribute__((ext_vector_type(8)));
typedef float f32x4 __attribute__((ext_vector_type(4)));

#define NT 256
constexpr int D = 1024, SEQ = 4096, NB = 8, CTXL = 256;
constexpr int ROWS_L = NB * SEQ;
constexpr int ROWS_C = NB * CTXL;
constexpr int ROWS = ROWS_L + ROWS_C;
constexpr int FFN = 2816;
constexpr int NIN0 = 2560, NIN1 = 2080, NIN1P = 2176;
constexpr int MODN = 6144;
constexpr int LDK = 72;

constexpr size_t MiB = (size_t)1 << 20;
constexpr size_t OFF_WIN0 = 0, OFF_WOUT0 = 5 * MiB, OFF_WGU0 = 7 * MiB, OFF_WD0 = 18 * MiB;
constexpr size_t OFF_WIN1 = 24 * MiB, OFF_WOUT1 = 29 * MiB, OFF_WGU1 = 31 * MiB, OFF_WD1 = 42 * MiB;
constexpr size_t OFF_MOD = 48 * MiB;
constexpr size_t OFF_TAB = 48 * MiB + 512 * 1024;
constexpr size_t OFF_BAR = 48 * MiB + 768 * 1024;
constexpr size_t OFF_XRES = 49 * MiB;
constexpr size_t OFF_HM = 185 * MiB;
constexpr size_t OFF_BIG = 253 * MiB;
constexpr size_t OFF_APR = OFF_BIG + 145 * MiB;
constexpr size_t OFF_API = OFF_BIG + 161 * MiB;
constexpr size_t OFF_EXTRA = 440 * MiB;
constexpr size_t WS_NEED = 508 * MiB;

struct Params {
  const float *x, *c, *ctx, *c_ctx, *ada_w, *ada_b, *norm_mix_w, *norm_ffn_w, *ffn_w_gate, *ffn_w_up, *ffn_w_down;
  const float *ab_w_in, *ab_w_out, *ab_sgu_norm_w, *ab_sgu_w, *ab_sgu_b, *ab_rel_bias;
  const float *cd_w_in, *cd_w_out, *cd_dw_f, *cd_db_f, *cd_dw_b, *cd_db_b, *cd_head_norm_w, *final_norm_w;
  float* out;
  char* ws;
};

__device__ __forceinline__ bf16_t f2bf(float f) {
  unsigned u = __float_as_uint(f);
  u += 0x7fffu + ((u >> 16) & 1u);
  return (bf16_t)(u >> 16);
}
__device__ __forceinline__ float bf2f(bf16_t h) { return __uint_as_float(((unsigned)h) << 16); }
__device__ __forceinline__ unsigned pack2(float a, float b) { return (unsigned)f2bf(a) | ((unsigned)f2bf(b) << 16); }
__device__ __forceinline__ float lo_bf(unsigned u) { return __uint_as_float(u << 16); }
__device__ __forceinline__ float hi_bf(unsigned u) { return __uint_as_float(u & 0xffff0000u); }
__device__ __forceinline__ float sigmoidf_(float x) { return 1.f / (1.f + __expf(-x)); }
__device__ __forceinline__ float siluf_(float x) { return x * sigmoidf_(x); }
__device__ __forceinline__ float geluf_(float x) {
  float u = 0.7978845608028654f * (x + 0.044715f * x * x * x);
  return x * sigmoidf_(2.f * u);
}
__device__ __forceinline__ float wave_sum(float v) {
#pragma unroll
  for (int o = 32; o > 0; o >>= 1) v += __shfl_xor(v, o);
  return v;
}
__device__ __forceinline__ float cos_rev(float r) { return __builtin_amdgcn_cosf(r); }
__device__ __forceinline__ float sin_rev(float r) { return __builtin_amdgcn_sinf(r); }

__device__ __forceinline__ void wt_tile(const float* __restrict__ src, const float* __restrict__ src2, int N, int ldsrc, bf16_t* __restrict__ dst,
                        int lddst, int kt, int ntile, int mode, float* tile) {
  const int tid = threadIdx.x;
#pragma unroll
  for (int i = 0; i < 4; ++i) {
    const int kk = (tid >> 4) + i * 16, j4 = (tid & 15) * 4;
    float4 v = make_float4(0.f, 0.f, 0.f, 0.f);
    if (mode == 0) {
      const int col = ntile * 64 + j4;
      if (col < N) v = *(const float4*)(src + (size_t)(kt * 64 + kk) * ldsrc + col);
    } else {
      const int col = ntile * 32 + (j4 & 31);
      const float* sp = (j4 < 32) ? src : src2;
      v = *(const float4*)(sp + (size_t)(kt * 64 + kk) * ldsrc + col);
    }
    tile[(j4 + 0) * 65 + kk] = v.x; tile[(j4 + 1) * 65 + kk] = v.y; tile[(j4 + 2) * 65 + kk] = v.z; tile[(j4 + 3) * 65 + kk] = v.w;
  }
  __syncthreads();
#pragma unroll
  for (int i = 0; i < 2; ++i) {
    const int e = tid + i * 256, j = e >> 3, k8 = (e & 7) * 8;
    const float* tp = tile + j * 65 + k8;
    uint4 pk; pk.x = pack2(tp[0], tp[1]); pk.y = pack2(tp[2], tp[3]); pk.z = pack2(tp[4], tp[5]); pk.w = pack2(tp[6], tp[7]);
    *(uint4*)(dst + (size_t)(ntile * 64 + j) * lddst + kt * 64 + k8) = pk;
  }
  __syncthreads();
}

__device__ __forceinline__ void mod_item(const Params& p, int item, float* sm) {
  const int l = item / 96, cgp = item % 96;
  const int tid = threadIdx.x, nn = tid & 63, ks = tid >> 6;
  float* sil = sm;
  float* red = sm + 4 * 9 * 256;
  for (int e = tid; e < 9 * 1024; e += NT) {
    int v = e >> 10, k = e & 1023;
    float cv = (v < 8) ? p.c[v * 1024 + k] : p.c_ctx[k];
    sil[((k >> 8) * 9 + v) * 256 + (k & 255)] = siluf_(cv);
  }
  __syncthreads();
  float acc[9];
#pragma unroll
  for (int v = 0; v < 9; ++v) acc[v] = 0.f;
  const float* w = p.ada_w + (size_t)l * 1024 * MODN + cgp * 64 + nn;
#pragma unroll 16
  for (int k = 0; k < 256; ++k) {
    float wv = w[(size_t)(ks * 256 + k) * MODN];
#pragma unroll
    for (int v = 0; v < 9; ++v) acc[v] += sil[(ks * 9 + v) * 256 + k] * wv;
  }
#pragma unroll
  for (int v = 0; v < 9; ++v) red[(ks * 9 + v) * 64 + nn] = acc[v];
  __syncthreads();
  float* mod = (float*)(p.ws + OFF_MOD);
  for (int e = tid; e < 9 * 64; e += NT) {
    int v = e >> 6, n = e & 63;
    float s = red[(0 * 9 + v) * 64 + n] + red[(1 * 9 + v) * 64 + n] + red[(2 * 9 + v) * 64 + n] + red[(3 * 9 + v) * 64 + n];
    mod[((size_t)l * 9 + v) * MODN + cgp * 64 + n] = s + p.ada_b[l * MODN + cgp * 64 + n];
  }
  __syncthreads();
}

__device__ __forceinline__ void phase_prep(const Params& p, char* smem) {
  float* sm = (float*)smem;
  bf16_t* W = (bf16_t*)p.ws;
  const int n_in0 = 16 * 40, n_out = 16 * 16, n_gu = 16 * 88, n_d = 44 * 16, n_in1 = 16 * 34;
  const int c0 = n_in0, c1 = c0 + n_out, c2 = c1 + n_gu, c3 = c2 + n_d, c4 = c3 + n_in1, c5 = c4 + n_out, c6 = c5 + n_gu, c7 = c6 + n_d;
  const int total = c7 + 192 + 1;
  for (int it = blockIdx.x; it < total; it += gridDim.x) {
    if (it < c0) { int t = it; wt_tile(p.ab_w_in, nullptr, NIN0, NIN0, (bf16_t*)(p.ws + OFF_WIN0), 1024, t / 40, t % 40, 0, sm); }
    else if (it < c1) { int t = it - c0; wt_tile(p.ab_w_out, nullptr, 1024, 1024, (bf16_t*)(p.ws + OFF_WOUT0), 1024, t / 16, t % 16, 0, sm); }
    else if (it < c2) { int t = it - c1; wt_tile(p.ffn_w_gate, p.ffn_w_up, FFN, FFN, (bf16_t*)(p.ws + OFF_WGU0), 1024, t / 88, t % 88, 1, sm); }
    else if (it < c3) { int t = it - c2; wt_tile(p.ffn_w_down, nullptr, 1024, 1024, (bf16_t*)(p.ws + OFF_WD0), FFN, t / 16, t % 16, 0, sm); }
    else if (it < c4) { int t = it - c3; wt_tile(p.cd_w_in, nullptr, NIN1, NIN1, (bf16_t*)(p.ws + OFF_WIN1), 1024, t / 34, t % 34, 0, sm); }
    else if (it < c5) { int t = it - c4; wt_tile(p.cd_w_out, nullptr, 1024, 1024, (bf16_t*)(p.ws + OFF_WOUT1), 1024, t / 16, t % 16, 0, sm); }
    else if (it < c6) { int t = it - c5; wt_tile(p.ffn_w_gate + (size_t)1024 * FFN, p.ffn_w_up + (size_t)1024 * FFN, FFN, FFN, (bf16_t*)(p.ws + OFF_WGU1), 1024, t / 88, t % 88, 1, sm); }
    else if (it < c7) { int t = it - c6; wt_tile(p.ffn_w_down + (size_t)FFN * 1024, nullptr, 1024, 1024, (bf16_t*)(p.ws + OFF_WD1), FFN, t / 16, t % 16, 0, sm); }
    else if (it < c7 + 192) { mod_item(p, it - c7, sm); }
    else {
      float* tab = (float*)(p.ws + OFF_TAB);
      for (int e = threadIdx.x; e < 128; e += NT) { tab[e] = cos_rev(e / 128.f); tab[128 + e] = sin_rev(e / 128.f); }
      for (int e = threadIdx.x; e < 64; e += NT) { tab[256 + e] = cos_rev(e / 64.f); tab[320 + e] = sin_rev(e / 64.f); }
      for (int e = threadIdx.x; e < 4096; e += NT) { tab[384 + e] = cos_rev(e / 4096.f); tab[4480 + e] = sin_rev(e / 4096.f); }
      for (int e = threadIdx.x; e < 1024; e += NT) {
        int pos = e >> 4, i = e & 15;
        float inv = __expf(-(float)i / 16.f * 9.210340371976184f);
        float ang = (float)pos * inv;
        float rev = ang * 0.15915494309189535f;
        rev = rev - floorf(rev);
        tab[8576 + e] = cos_rev(rev); tab[9600 + e] = sin_rev(rev);
      }
      bf16_t* t1 = (bf16_t*)(p.ws + OFF_TAB + 65536);
      for (int e = threadIdx.x; e < 32768; e += NT) {
        const int n = e >> 7, cidx = e & 127;
        const float rev = (float)((cidx * (n & 127)) & 127) / 128.f;
        t1[e] = f2bf(n < 128 ? cos_rev(rev) : -sin_rev(rev));
      }
      bf16_t* c64 = t1 + 32768;
      for (int e = threadIdx.x; e < 4096; e += NT) {
        const float rev = (float)(((e >> 6) * (e & 63)) & 63) / 64.f;
        const float cv = cos_rev(rev), sv = sin_rev(rev);
        c64[e] = f2bf(cv); c64[4096 + e] = f2bf(sv); c64[8192 + e] = f2bf(-sv);
      }
    }
  }
}

__device__ __forceinline__ void phase_norm(const float* __restrict__ src_lat, const float* __restrict__ src_ctx, const float* __restrict__ w,
                           const float* __restrict__ modl  , int sh_off, int sc_off, bf16_t* __restrict__ dst, int nrows) {
  const int lane = threadIdx.x & 63, wid = threadIdx.x >> 6;
  for (int r = blockIdx.x * 4 + wid; r < nrows; r += gridDim.x * 4) {
    const float* s = (r < ROWS_L) ? src_lat + (size_t)r * 1024 : src_ctx + (size_t)(r - ROWS_L) * 1024;
    const int vec = (r < ROWS_L) ? (r >> 12) : 8;
    const float* mv = modl + (size_t)vec * MODN;
    float4 v[4];
    float ss = 0.f;
#pragma unroll
    for (int i = 0; i < 4; ++i) {
      v[i] = *(const float4*)(s + i * 256 + lane * 4);
      ss += v[i].x * v[i].x + v[i].y * v[i].y + v[i].z * v[i].z + v[i].w * v[i].w;
    }
    ss = wave_sum(ss);
    const float rstd = rsqrtf(ss * (1.f / 1024.f) + 1e-6f);
#pragma unroll
    for (int i = 0; i < 4; ++i) {
      const int cidx = i * 256 + lane * 4;
      float4 wv = *(const float4*)(w + cidx);
      float4 sc = *(const float4*)(mv + sc_off + cidx);
      float4 sh = *(const float4*)(mv + sh_off + cidx);
      float o0 = v[i].x * rstd * wv.x * (1.f + sc.x) + sh.x;
      float o1 = v[i].y * rstd * wv.y * (1.f + sc.y) + sh.y;
      float o2 = v[i].z * rstd * wv.z * (1.f + sc.z) + sh.z;
      float o3 = v[i].w * rstd * wv.w * (1.f + sc.w) + sh.w;
      uint2 pk; pk.x = pack2(o0, o1); pk.y = pack2(o2, o3);
      *(uint2*)(dst + (size_t)r * 1024 + cidx) = pk;
    }
  }
}

__device__ __forceinline__ void phase_final_norm(const float* __restrict__ src, const float* __restrict__ w, float* __restrict__ dst) {
  const int lane = threadIdx.x & 63, wid = threadIdx.x >> 6;
  for (int r = blockIdx.x * 4 + wid; r < ROWS_L; r += gridDim.x * 4) {
    const float* s = src + (size_t)r * 1024;
    float4 v[4];
    float ss = 0.f;
#pragma unroll
    for (int i = 0; i < 4; ++i) {
      v[i] = *(const float4*)(s + i * 256 + lane * 4);
      ss += v[i].x * v[i].x + v[i].y * v[i].y + v[i].z * v[i].z + v[i].w * v[i].w;
    }
    ss = wave_sum(ss);
    const float rstd = rsqrtf(ss * (1.f / 1024.f) + 1e-6f);
#pragma unroll
    for (int i = 0; i < 4; ++i) {
      const int cidx = i * 256 + lane * 4;
      float4 wv = *(const float4*)(w + cidx);
      float4 o; o.x = v[i].x * rstd * wv.x; o.y = v[i].y * rstd * wv.y; o.z = v[i].z * rstd * wv.z; o.w = v[i].w * rstd * wv.w;
      *(float4*)(dst + (size_t)r * 1024 + cidx) = o;
    }
  }
}

struct Epi {
  bf16_t* C; int ldc; int gelu_cols;
  const float* src_lat; const float* src_ctx;
  float* dst;
  const float* gate;
};

template <int EPI, int IM>
__device__ __forceinline__ void gemm_tiles(const bf16_t* __restrict__ A, int lda, const bf16_t* __restrict__ Bt, int K, int mrow0, int Mrows, int N,
                           int blk_shift, char* smem, const Epi ep) {
  const int tid = threadIdx.x, lane = tid & 63, wid = tid >> 6, wm = wid >> 1, wn = wid & 1;
  const int fr = lane & 15, fq = lane >> 4;
  const int nMt = Mrows / (IM * 32), nNt = N / 128, ntiles = nMt * nNt, nk = K / 64;
  const int drow = lane >> 3, dkc = (lane & 7) ^ (lane >> 3);
  const int ko0 = ((fq) ^ (fr & 7)) * 16, ko1 = ((4 + fq) ^ (fr & 7)) * 16;
  const int vb0 = (int)(blockIdx.x & 7u) * (int)(gridDim.x >> 3) + (int)(blockIdx.x >> 3);
  const int vb = (vb0 + (int)gridDim.x - blk_shift) % (int)gridDim.x;
  for (int tile = vb; tile < ntiles; tile += gridDim.x) {
    const int grp = tile / (8 * nNt), wi = tile % (8 * nNt);
    const int mt = grp * 8 + (wi & 7), nt = wi >> 3;
    const int m0 = mrow0 + mt * (IM * 32), n0 = nt * 128;
    f32x4 acc[IM][4];
#pragma unroll
    for (int i = 0; i < IM; ++i)
#pragma unroll
      for (int j = 0; j < 4; ++j) acc[i][j] = (f32x4){0.f, 0.f, 0.f, 0.f};
    const bf16_t* gA = A + (size_t)(m0 + wid * (IM * 8) + drow) * lda + dkc * 8;
    const bf16_t* gB = Bt + (size_t)(n0 + wid * 32 + drow) * K + dkc * 8;
    auto dma_a = [&](int kt_) {
      char* sb_ = smem + lane * 16;
#pragma unroll
      for (int i = 0; i < IM; ++i)
        __builtin_amdgcn_global_load_lds((const unsigned*)(gA + (size_t)i * 8 * lda + kt_ * 64), (unsigned*)(sb_ + (wid * IM + i) * 1024), 16, 0, 0);
    };
    auto dma_b = [&](int kt_) {
      char* sb_ = smem + 32768 + (kt_ & 1) * 16384 + lane * 16;
#pragma unroll
      for (int i = 0; i < 4; ++i)
        __builtin_amdgcn_global_load_lds((const unsigned*)(gB + (size_t)i * 8 * K + kt_ * 64), (unsigned*)(sb_ + (wid * 4 + i) * 1024), 16, 0, 0);
    };
    const char* as = smem + (wm * (IM * 16) + fr) * 128;
    asm volatile("s_waitcnt vmcnt(0)" ::: "memory");
    __syncthreads();
    dma_a(0); dma_b(0);
    for (int kt = 0; kt < nk; ++kt) {
      asm volatile("s_waitcnt vmcnt(0)" ::: "memory");
      __builtin_amdgcn_s_barrier();
      asm volatile("" ::: "memory");
      if (kt + 1 < nk) dma_b(kt + 1);
      const char* bs = smem + 32768 + (kt & 1) * 16384 + (wn * 64 + fr) * 128;
      bf16x8 af[IM], bfr[4];
#pragma unroll
      for (int j = 0; j < 4; ++j) bfr[j] = *(const bf16x8*)(bs + j * 2048 + ko0);
#pragma unroll
      for (int i = 0; i < IM; ++i) af[i] = *(const bf16x8*)(as + i * 2048 + ko0);
      __builtin_amdgcn_sched_barrier(0);
#pragma unroll
      for (int i = 0; i < IM; ++i)
#pragma unroll
        for (int j = 0; j < 4; ++j) acc[i][j] = __builtin_amdgcn_mfma_f32_16x16x32_bf16(bfr[j], af[i], acc[i][j], 0, 0, 0);
      __builtin_amdgcn_sched_barrier(0);
#pragma unroll
      for (int j = 0; j < 4; ++j) bfr[j] = *(const bf16x8*)(bs + j * 2048 + ko1);
#pragma unroll
      for (int i = 0; i < IM; ++i) af[i] = *(const bf16x8*)(as + i * 2048 + ko1);
      __builtin_amdgcn_sched_barrier(0);
      asm volatile("s_waitcnt lgkmcnt(0)" ::: "memory");
      __builtin_amdgcn_s_barrier();
      asm volatile("" ::: "memory");
      if (kt + 1 < nk) dma_a(kt + 1);
      __builtin_amdgcn_sched_barrier(0);
#pragma unroll
      for (int i = 0; i < IM; ++i)
#pragma unroll
        for (int j = 0; j < 4; ++j) acc[i][j] = __builtin_amdgcn_mfma_f32_16x16x32_bf16(bfr[j], af[i], acc[i][j], 0, 0, 0);
      __builtin_amdgcn_sched_barrier(0);
    }
    if (EPI == 0) {
      const bool do_gelu = n0 < ep.gelu_cols;
#pragma unroll
      for (int i = 0; i < IM; ++i) {
        const int m = m0 + wm * (IM * 16) + i * 16 + fr;
#pragma unroll
        for (int j = 0; j < 4; ++j) {
          const int n = n0 + wn * 64 + j * 16 + fq * 4;
          f32x4 v = acc[i][j];
          if (do_gelu) { v[0] = geluf_(v[0]); v[1] = geluf_(v[1]); v[2] = geluf_(v[2]); v[3] = geluf_(v[3]); }
          uint2 pk; pk.x = pack2(v[0], v[1]); pk.y = pack2(v[2], v[3]);
          *(uint2*)(ep.C + (size_t)m * ep.ldc + n) = pk;
        }
      }
    } else if (EPI == 1) {
      const int vec = (m0 < ROWS_L) ? (m0 >> 12) : 8;
      const float* gv = ep.gate + (size_t)vec * MODN;
#pragma unroll
      for (int i = 0; i < IM; ++i) {
        const int m = m0 + wm * (IM * 16) + i * 16 + fr;
        const float* srow_p = (m < ROWS_L) ? ep.src_lat + (size_t)m * 1024 : ep.src_ctx + (size_t)(m - ROWS_L) * 1024;
#pragma unroll
        for (int j = 0; j < 4; ++j) {
          const int n = n0 + wn * 64 + j * 16 + fq * 4;
          float4 sv = *(const float4*)(srow_p + n);
          float4 g = *(const float4*)(gv + n);
          float4 o;
          o.x = sv.x + g.x * acc[i][j][0]; o.y = sv.y + g.y * acc[i][j][1];
          o.z = sv.z + g.z * acc[i][j][2]; o.w = sv.w + g.w * acc[i][j][3];
          *(float4*)(ep.dst + (size_t)m * 1024 + n) = o;
        }
      }
    } else {
#pragma unroll
      for (int i = 0; i < IM; ++i) {
        const int m = m0 + wm * (IM * 16) + i * 16 + fr;
#pragma unroll
        for (int j = 0; j < 2; ++j) {
          const int n = (n0 >> 1) + wn * 32 + j * 16 + fq * 4;
          f32x4 g = acc[i][j], u = acc[i][j + 2];
          uint2 pk;
          pk.x = pack2(siluf_(g[0]) * u[0], siluf_(g[1]) * u[1]);
          pk.y = pack2(siluf_(g[2]) * u[2], siluf_(g[3]) * u[3]);
          *(uint2*)(ep.C + (size_t)m * ep.ldc + n) = pk;
        }
      }
    }
  }
}


template <int EPI>
__device__ __forceinline__ void gemm_phase(const bf16_t* __restrict__ A, int lda, const bf16_t* __restrict__ Bt, int K, int Mrows, int N,
                           char* smem, const Epi ep) {
  gemm_tiles<EPI, 8>(A, lda, Bt, K, 0, ROWS_L, N, 0, smem, ep);
  if (Mrows > ROWS_L) {
    const int lat_tiles = (ROWS_L / 256) * (N / 128);
    gemm_tiles<EPI, 4>(A, lda, Bt, K, ROWS_L, Mrows - ROWS_L, N, lat_tiles % (int)gridDim.x, smem, ep);
  }
}

__device__ __forceinline__ void sgu_item(const Params& p, int ck, int g, const bf16_t* __restrict__ pb, bf16_t* __restrict__ mix, char* smem) {
  constexpr int LDV = 136;
  bf16_t* vnT = (bf16_t*)smem;
  int tid = threadIdx.x;
  asm volatile("" : "+v"(tid));
  const int r0 = ck * 128;
  {
    const int q = tid >> 1, half = tid & 1;
    const bf16_t* vrow = pb + (size_t)(r0 + q) * NIN0 + 512 + half * 256;
    float ss = 0.f;
#pragma unroll 4
    for (int i = 0; i < 32; ++i) {
      uint4 u = *(const uint4*)(vrow + i * 8);
      float a;
      a = lo_bf(u.x); ss += a * a; a = hi_bf(u.x); ss += a * a;
      a = lo_bf(u.y); ss += a * a; a = hi_bf(u.y); ss += a * a;
      a = lo_bf(u.z); ss += a * a; a = hi_bf(u.z); ss += a * a;
      a = lo_bf(u.w); ss += a * a; a = hi_bf(u.w); ss += a * a;
    }
    ss += __shfl_xor(ss, 1);
    const float rstd = rsqrtf(ss * (1.f / 512.f) + 1e-6f);
    const bf16_t* vg = pb + (size_t)(r0 + q) * NIN0 + 512 + g * 128 + half * 64;
    const float* nw = p.ab_sgu_norm_w + g * 128 + half * 64;
#pragma unroll 2
    for (int i = 0; i < 8; ++i) {
      const uint4 u = *(const uint4*)(vg + i * 8);
      const float4 w0 = *(const float4*)(nw + i * 8), w1 = *(const float4*)(nw + i * 8 + 4);
      bf16_t* dp = vnT + (half * 64 + i * 8) * LDV + q;
      dp[0 * LDV] = f2bf(lo_bf(u.x) * rstd * w0.x); dp[1 * LDV] = f2bf(hi_bf(u.x) * rstd * w0.y);
      dp[2 * LDV] = f2bf(lo_bf(u.y) * rstd * w0.z); dp[3 * LDV] = f2bf(hi_bf(u.y) * rstd * w0.w);
      dp[4 * LDV] = f2bf(lo_bf(u.z) * rstd * w1.x); dp[5 * LDV] = f2bf(hi_bf(u.z) * rstd * w1.y);
      dp[6 * LDV] = f2bf(lo_bf(u.w) * rstd * w1.z); dp[7 * LDV] = f2bf(hi_bf(u.w) * rstd * w1.w);
    }
  }
  __syncthreads();
  {
    const int lane = tid & 63, wv = tid >> 6, fr = lane & 15, fq = lane >> 4;
    const float* W = p.ab_sgu_w + (size_t)g * 128 * 128;
    f32x4 acc[2][8];
#pragma unroll
    for (int i = 0; i < 2; ++i)
#pragma unroll
      for (int j = 0; j < 8; ++j) acc[i][j] = (f32x4){0.f, 0.f, 0.f, 0.f};
#pragma unroll
    for (int s4 = 0; s4 < 4; ++s4) {
      bf16x8 af[2];
#pragma unroll
      for (int i = 0; i < 2; ++i) {
        const float* wp = W + (wv * 32 + i * 16 + fr) * 128 + s4 * 32 + fq * 8;
        const float4 a0 = *(const float4*)wp, a1 = *(const float4*)(wp + 4);
        uint4 pk; pk.x = pack2(a0.x, a0.y); pk.y = pack2(a0.z, a0.w); pk.z = pack2(a1.x, a1.y); pk.w = pack2(a1.z, a1.w);
        af[i] = *(bf16x8*)&pk;
      }
#pragma unroll
      for (int j = 0; j < 8; ++j) {
        const bf16x8 bfr = *(const bf16x8*)(vnT + (j * 16 + fr) * LDV + s4 * 32 + fq * 8);
        acc[0][j] = __builtin_amdgcn_mfma_f32_16x16x32_bf16(bfr, af[0], acc[0][j], 0, 0, 0);
        acc[1][j] = __builtin_amdgcn_mfma_f32_16x16x32_bf16(bfr, af[1], acc[1][j], 0, 0, 0);
      }
    }
#pragma unroll
    for (int i = 0; i < 2; ++i) {
      const int pp = wv * 32 + i * 16 + fr;
      const float bias = p.ab_sgu_b[g * 128 + pp];
#pragma unroll
      for (int j = 0; j < 8; ++j) {
        const int cc = j * 16 + fq * 4;
        const uint2 uu = *(const uint2*)(pb + (size_t)(r0 + pp) * NIN0 + g * 128 + cc);
        uint2 pk;
        pk.x = pack2(lo_bf(uu.x) * (acc[i][j][0] + bias), hi_bf(uu.x) * (acc[i][j][1] + bias));
        pk.y = pack2(lo_bf(uu.y) * (acc[i][j][2] + bias), hi_bf(uu.y) * (acc[i][j][3] + bias));
        *(uint2*)(mix + (size_t)(r0 + pp) * 1024 + g * 128 + cc) = pk;
      }
    }
  }
  __syncthreads();
}

__device__ __forceinline__ void attn_item(const Params& p, bool latent, int b, int rq, int h, const bf16_t* __restrict__ pb, bf16_t* __restrict__ mix, char* smem) {
  int tid = threadIdx.x;
  asm volatile("" : "+v"(tid));
  const int lane = tid & 63, wv = tid >> 6, fr = lane & 15, fq = lane >> 4;
  const int qcol = wv * 16 + fr;
  const int qrow = latent ? (b * 4096 + rq * 64 + qcol) : (ROWS_L + b * 256 + rq * 64 + qcol);
  const int nnb = latent ? 8 : 0, nblk = nnb + 4;
  const int row_start = min(max(rq - 4, 0), 56);
  const int col_start = min(max(qcol - 8, 0), 48);
  const int kc0 = min(max(wv * 16 - 8, 0), 32);
  bf16x8 qf[2];
#pragma unroll
  for (int s2 = 0; s2 < 2; ++s2) {
    const uint4 u = *(const uint4*)(pb + (size_t)qrow * NIN0 + 1024 + h * 64 + s2 * 32 + fq * 8);
    uint4 v;
    v.x = pack2(lo_bf(u.x) * 0.125f, hi_bf(u.x) * 0.125f); v.y = pack2(lo_bf(u.y) * 0.125f, hi_bf(u.y) * 0.125f);
    v.z = pack2(lo_bf(u.z) * 0.125f, hi_bf(u.z) * 0.125f); v.w = pack2(lo_bf(u.w) * 0.125f, hi_bf(u.w) * 0.125f);
    qf[s2] = *(bf16x8*)&v;
  }
  f32x4 o[4];
#pragma unroll
  for (int dt = 0; dt < 4; ++dt) o[dt] = (f32x4){0.f, 0.f, 0.f, 0.f};
  float mrow = -1e30f, lsum = 0.f;
  uint4 rk[2], rv[2];
  auto blk_row = [&](int kb) -> int { return (kb < nnb) ? (b * 4096 + (row_start + kb) * 64) : (ROWS_L + b * 256 + (kb - nnb) * 64); };
  auto gload = [&](int kb) {
    const int r0 = blk_row(kb);
#pragma unroll
    for (int i = 0; i < 2; ++i) {
      const int sidx = tid + i * 256, key = sidx & 63, c8 = sidx >> 6;
      const bf16_t* rp = pb + (size_t)(r0 + key) * NIN0 + h * 64 + c8 * 8;
      rk[i] = *(const uint4*)(rp + 1536);
      rv[i] = *(const uint4*)(rp + 2048);
    }
  };
  auto lstore = [&](int buf) {
    bf16_t* kb_ = (bf16_t*)(smem + buf * 18432);
    bf16_t* vt_ = (bf16_t*)(smem + buf * 18432 + 9216);
#pragma unroll
    for (int i = 0; i < 2; ++i) {
      const int sidx = tid + i * 256, key = sidx & 63, c8 = sidx >> 6;
      *(uint4*)(kb_ + key * LDK + c8 * 8) = rk[i];
      bf16_t* dp = vt_ + (c8 * 8) * LDK + key;
      const uint4 u = rv[i];
      dp[0 * LDK] = (bf16_t)(u.x & 0xffff); dp[1 * LDK] = (bf16_t)(u.x >> 16);
      dp[2 * LDK] = (bf16_t)(u.y & 0xffff); dp[3 * LDK] = (bf16_t)(u.y >> 16);
      dp[4 * LDK] = (bf16_t)(u.z & 0xffff); dp[5 * LDK] = (bf16_t)(u.z >> 16);
      dp[6 * LDK] = (bf16_t)(u.w & 0xffff); dp[7 * LDK] = (bf16_t)(u.w >> 16);
    }
  };
  gload(0);
  lstore(0);
  __syncthreads();
  for (int kb = 0; kb < nblk; ++kb) {
    const int buf = kb & 1;
    if (kb + 1 < nblk) gload(kb + 1);
    const bf16_t* kbuf = (const bf16_t*)(smem + buf * 18432);
    const bf16_t* vtb = (const bf16_t*)(smem + buf * 18432 + 9216);
    const bool nb = kb < nnb;
    const int k0 = nb ? kc0 : 0;
    const int ntile = nb ? 2 : 4;
    f32x4 sc[4];
#pragma unroll
    for (int j = 0; j < 4; ++j) sc[j] = (f32x4){0.f, 0.f, 0.f, 0.f};
#pragma unroll
    for (int j = 0; j < 4; ++j) {
      if (j < ntile) {
#pragma unroll
        for (int s2 = 0; s2 < 2; ++s2) {
          const bf16x8 kf = *(const bf16x8*)(kbuf + (k0 + j * 16 + fr) * LDK + s2 * 32 + fq * 8);
          sc[j] = __builtin_amdgcn_mfma_f32_16x16x32_bf16(kf, qf[s2], sc[j], 0, 0, 0);
        }
      }
    }
    float bm = -1e30f;
    if (nb) {
      const int dr = row_start + kb - rq + 7;
      const float* bp = p.ab_rel_bias + (h * 15 + dr) * 31 + 15 - qcol;
#pragma unroll
      for (int j = 0; j < 2; ++j)
#pragma unroll
        for (int r = 0; r < 4; ++r) {
          const int kc = k0 + j * 16 + fq * 4 + r;
          const bool ok = (kc >= col_start) && (kc < col_start + 16);
          const float v = ok ? sc[j][r] + bp[ok ? kc : qcol] : -1e30f;
          sc[j][r] = v;
          bm = fmaxf(bm, v);
        }
    } else {
#pragma unroll
      for (int j = 0; j < 4; ++j)
#pragma unroll
        for (int r = 0; r < 4; ++r) bm = fmaxf(bm, sc[j][r]);
    }
    bm = fmaxf(bm, __shfl_xor(bm, 16));
    bm = fmaxf(bm, __shfl_xor(bm, 32));
    const float mnew = fmaxf(mrow, bm);
    const float corr = __expf(mrow - mnew);
    mrow = mnew;
    float ps = 0.f;
#pragma unroll
    for (int j = 0; j < 4; ++j)
#pragma unroll
      for (int r = 0; r < 4; ++r) {
        const float pe = (j < ntile) ? __expf(sc[j][r] - mnew) : 0.f;
        sc[j][r] = pe;
        ps += pe;
      }
    lsum = lsum * corr + ps;
#pragma unroll
    for (int dt = 0; dt < 4; ++dt) { o[dt][0] *= corr; o[dt][1] *= corr; o[dt][2] *= corr; o[dt][3] *= corr; }
#pragma unroll
    for (int jp = 0; jp < 2; ++jp) {
      if (jp * 2 < ntile) {
        uint4 pk;
        pk.x = pack2(sc[2 * jp][0], sc[2 * jp][1]); pk.y = pack2(sc[2 * jp][2], sc[2 * jp][3]);
        pk.z = pack2(sc[2 * jp + 1][0], sc[2 * jp + 1][1]); pk.w = pack2(sc[2 * jp + 1][2], sc[2 * jp + 1][3]);
        const bf16x8 pf = *(bf16x8*)&pk;
#pragma unroll
        for (int dt = 0; dt < 4; ++dt) {
          const bf16_t* vp = vtb + (dt * 16 + fr) * LDK + k0 + jp * 32 + fq * 4;
          uint4 vv;
          const uint2 lo = *(const uint2*)vp, hi = *(const uint2*)(vp + 16);
          vv.x = lo.x; vv.y = lo.y; vv.z = hi.x; vv.w = hi.y;
          o[dt] = __builtin_amdgcn_mfma_f32_16x16x32_bf16(*(bf16x8*)&vv, pf, o[dt], 0, 0, 0);
        }
      }
    }
    if (kb + 1 < nblk) lstore(buf ^ 1);
    __syncthreads();
  }
  lsum += __shfl_xor(lsum, 16);
  lsum += __shfl_xor(lsum, 32);
  const float inv = 1.f / lsum;
#pragma unroll
  for (int dt = 0; dt < 4; ++dt) {
    uint2 pk; pk.x = pack2(o[dt][0] * inv, o[dt][1] * inv); pk.y = pack2(o[dt][2] * inv, o[dt][3] * inv);
    *(uint2*)(mix + (size_t)qrow * 1024 + 512 + h * 64 + dt * 16 + fq * 4) = pk;
  }
}

__device__ __forceinline__ void phase_mix0(const Params& p, char* smem) {
  const bf16_t* pb = (const bf16_t*)(p.ws + OFF_BIG);
  bf16_t* mix = (bf16_t*)(p.ws + OFF_HM);
  const int n_sgu = 272 * 4, n_al = 8 * 64 * 8, n_ac = 8 * 4 * 8;
  const int total = n_sgu + n_al + n_ac;
  for (int it = blockIdx.x; it < total; it += gridDim.x) {
    if (it < n_al) { int t = it; attn_item(p, true, t >> 9, (t >> 3) & 63, t & 7, pb, mix, smem); }
    else if (it < n_al + n_ac) { int t = it - n_al; attn_item(p, false, t >> 5, (t >> 3) & 3, t & 7, pb, mix, smem); }
    else { int t = it - n_al - n_ac; sgu_item(p, t >> 2, t & 3, pb, mix, smem); }
  }
}


constexpr size_t OFF_DEC = OFF_BIG + 177 * MiB;
template <int NJ>
__device__ __forceinline__ void wave_mma_lds(const bf16_t* A, const bf16_t* Bt, f32x4 (&acc)[NJ], int fr, int fq) {
#pragma unroll
  for (int s = 0; s < 2; ++s) {
    const bf16x8 a = *(const bf16x8*)(A + fr * LDK + s * 32 + fq * 8);
#pragma unroll
    for (int j = 0; j < NJ; ++j) {
      const bf16x8 b = *(const bf16x8*)(Bt + (j * 16 + fr) * LDK + s * 32 + fq * 8);
      acc[j] = __builtin_amdgcn_mfma_f32_16x16x32_bf16(b, a, acc[j], 0, 0, 0);
    }
  }
}
template <int NJ>
__device__ __forceinline__ void wave_mma_glb(const bf16_t* A, const bf16_t* Btg, f32x4 (&acc)[NJ], int fr, int fq) {
#pragma unroll
  for (int s = 0; s < 2; ++s) {
    const bf16x8 a = *(const bf16x8*)(A + fr * LDK + s * 32 + fq * 8);
#pragma unroll
    for (int j = 0; j < NJ; ++j) {
      const bf16x8 b = *(const bf16x8*)(Btg + (j * 16 + fr) * 64 + s * 32 + fq * 8);
      acc[j] = __builtin_amdgcn_mfma_f32_16x16x32_bf16(b, a, acc[j], 0, 0, 0);
    }
  }
}

template <bool LATENT, bool WANT_OUT, bool WANT_KV>
__device__ __forceinline__ void gla_prep(const Params& p, const bf16_t* __restrict__ pb, int rbase, int h, int dir, int n, char* smem, float* decay_out) {
  bf16_t* kraw = (bf16_t*)smem;
  bf16_t* qraw = (bf16_t*)(smem + 8192);
  float* tot = (float*)(smem + 16384);
  bf16_t* qe = (bf16_t*)(smem + 17408);
  bf16_t* kinv = (bf16_t*)(smem + 26624);
  bf16_t* kdecT = (bf16_t*)(smem + 35840);
  const float* tab = (const float*)(p.ws + OFF_TAB);
  int tid = threadIdx.x;
  asm volatile("" : "+v"(tid));
  const int d = tid & 63, lq = tid >> 6;
#pragma unroll
  for (int i = 0; i < 2; ++i) {
    const int idx = tid + i * 256, l = idx >> 3, c8 = idx & 7;
    const bf16_t* rp = pb + (size_t)(rbase + l) * NIN1P + h * 64 + c8 * 8;
    *(uint4*)(kraw + l * 64 + c8 * 8) = *(const uint4*)(rp + 768);
    if (WANT_OUT) *(uint4*)(qraw + l * 64 + c8 * 8) = *(const uint4*)(rp + 512);
  }
  bf16_t* araw = (bf16_t*)(smem + 63488);
  if (tid < 128) {
    const int l = tid >> 1, hf = tid & 1;
    *(uint4*)(araw + l * 16 + hf * 8) = *(const uint4*)(pb + (size_t)(rbase + l) * NIN1P + 2048 + dir * 16 + hf * 8);
  }
  const float* dw = dir ? p.cd_dw_b : p.cd_dw_f;
  const float* db = dir ? p.cd_db_b : p.cd_db_f;
  float w[16];
#pragma unroll
  for (int j = 0; j < 16; ++j) w[j] = dw[j * 256 + h * 64 + d];
  const float bias = db[h * 64 + d];
  float c[16];
  __syncthreads();
#pragma unroll
  for (int i = 0; i < 16; ++i) {
    const bf16_t* ap = araw + (lq * 16 + i) * 16;
    const uint4 u0 = *(const uint4*)ap, u1 = *(const uint4*)(ap + 8);
    float x = bias;
    x += lo_bf(u0.x) * w[0] + hi_bf(u0.x) * w[1] + lo_bf(u0.y) * w[2] + hi_bf(u0.y) * w[3];
    x += lo_bf(u0.z) * w[4] + hi_bf(u0.z) * w[5] + lo_bf(u0.w) * w[6] + hi_bf(u0.w) * w[7];
    x += lo_bf(u1.x) * w[8] + hi_bf(u1.x) * w[9] + lo_bf(u1.y) * w[10] + hi_bf(u1.y) * w[11];
    x += lo_bf(u1.z) * w[12] + hi_bf(u1.z) * w[13] + lo_bf(u1.w) * w[14] + hi_bf(u1.w) * w[15];
    c[i] = (fminf(x, 0.f) - __logf(1.f + __expf(-fabsf(x)))) * (1.f / 16.f);
    __builtin_amdgcn_sched_barrier(0);
  }
  if (dir == 0) {
#pragma unroll
    for (int i = 1; i < 16; ++i) c[i] += c[i - 1];
    tot[lq * 64 + d] = c[15];
  } else {
#pragma unroll
    for (int i = 14; i >= 0; --i) c[i] += c[i + 1];
    tot[lq * 64 + d] = c[0];
  }
  __syncthreads();
  const float t0 = tot[d], t1 = tot[64 + d], t2 = tot[128 + d], t3 = tot[192 + d];
  const float ctot = (t0 + t1) + (t2 + t3);
  float off;
  if (dir == 0) off = (lq > 0 ? t0 : 0.f) + (lq > 1 ? t1 : 0.f) + (lq > 2 ? t2 : 0.f);
  else off = (lq < 3 ? t3 : 0.f) + (lq < 2 ? t2 : 0.f) + (lq < 1 ? t1 : 0.f);
  float kd_prev = 0.f;
#pragma unroll
  for (int i = 0; i < 16; ++i) {
    const int l = lq * 16 + i;
    const float cc = c[i] + off;
    float kv = bf2f(kraw[l * 64 + d]);
    float qv = WANT_OUT ? bf2f(qraw[l * 64 + d]) : 0.f;
    if (LATENT) {
      const float kp = bf2f(kraw[l * 64 + (d ^ 16)]);
      const int pos = (d < 32) ? n : l;
      const float cs = tab[8576 + pos * 16 + (d & 15)], sn = tab[9600 + pos * 16 + (d & 15)];
      const float sg = (d & 16) ? sn : -sn;
      kv = kv * cs + kp * sg;
      if (WANT_OUT) { const float qp = bf2f(qraw[l * 64 + (d ^ 16)]); qv = qv * cs + qp * sg; }
    }
    if (WANT_OUT) {
      qe[l * LDK + d] = f2bf(qv * 0.125f * __expf(cc));
      kinv[l * LDK + d] = f2bf(kv * __expf(-cc));
    }
    if (WANT_KV) {
      const float kd = kv * __expf(ctot - cc);
      if (i & 1) *(unsigned*)(kdecT + d * LDK + l - 1) = pack2(kd_prev, kd);
      kd_prev = kd;
    }
    __builtin_amdgcn_sched_barrier(0);
  }
  if (WANT_KV && lq == 0) decay_out[d] = __expf(ctot);
}

__device__ __forceinline__ void gla_stage_vT(const bf16_t* __restrict__ pb, int rbase, int h, char* smem) {
  bf16_t* vT = (bf16_t*)(smem + 45056);
  const int tid = threadIdx.x;
#pragma unroll
  for (int i = 0; i < 4; ++i) {
    const int idx = tid + i * 256, l = idx & 63, e8 = idx >> 6;
    const uint4 u = *(const uint4*)(pb + (size_t)(rbase + l) * NIN1P + 1024 + h * 128 + e8 * 8);
    bf16_t* dp = vT + (e8 * 8) * LDK + l;
    dp[0 * LDK] = (bf16_t)(u.x & 0xffff); dp[1 * LDK] = (bf16_t)(u.x >> 16);
    dp[2 * LDK] = (bf16_t)(u.y & 0xffff); dp[3 * LDK] = (bf16_t)(u.y >> 16);
    dp[4 * LDK] = (bf16_t)(u.z & 0xffff); dp[5 * LDK] = (bf16_t)(u.z >> 16);
    dp[6 * LDK] = (bf16_t)(u.w & 0xffff); dp[7 * LDK] = (bf16_t)(u.w >> 16);
  }
}

__device__ __forceinline__ void gla_kv_item(const Params& p, int b, int h, int dir, int j, const bf16_t* __restrict__ pb, char* smem) {
  const int sidx = ((b * 4 + h) * 2 + dir) * 68 + j;
  bf16_t* slot = (bf16_t*)(p.ws + OFF_EXTRA) + (size_t)sidx * 8192;
  float* dec = (float*)(p.ws + OFF_DEC) + (size_t)sidx * 64;
  int rbase;
  if (j < 4) {
    const int nc = dir ? 3 - j : j;
    rbase = ROWS_L + b * 256 + nc * 64;
    gla_prep<false, false, true>(p, pb, rbase, h, dir, 0, smem, dec);
  } else {
    const int jj = j - 4, n = dir ? 63 - jj : jj;
    rbase = b * 4096 + n * 64;
    gla_prep<true, false, true>(p, pb, rbase, h, dir, n, smem, dec);
  }
  gla_stage_vT(pb, rbase, h, smem);
  __syncthreads();
  const bf16_t* kdecT = (const bf16_t*)(smem + 35840);
  const bf16_t* vT = (const bf16_t*)(smem + 45056);
  const int lane = threadIdx.x & 63, wv = threadIdx.x >> 6, fr = lane & 15, fq = lane >> 4;
#pragma unroll
  for (int i2 = 0; i2 < 2; ++i2) {
    f32x4 acc[4];
#pragma unroll
    for (int jn = 0; jn < 4; ++jn) acc[jn] = (f32x4){0.f, 0.f, 0.f, 0.f};
    wave_mma_lds<4>(vT + (wv * 32 + i2 * 16) * LDK, kdecT, acc, fr, fq);
    const int e = wv * 32 + i2 * 16 + fr;
#pragma unroll
    for (int jn = 0; jn < 4; ++jn) {
      uint2 pk; pk.x = pack2(acc[jn][0], acc[jn][1]); pk.y = pack2(acc[jn][2], acc[jn][3]);
      *(uint2*)(slot + e * 64 + jn * 16 + fq * 4) = pk;
    }
  }
  __syncthreads();
}

__device__ __forceinline__ void gla_scan_item(const Params& p, int bhd, int es) {
  const int tid = threadIdx.x, e = es * 32 + (tid >> 3), d0 = (tid & 7) * 8;
  bf16_t* base = (bf16_t*)(p.ws + OFF_EXTRA) + (size_t)bhd * 68 * 8192 + e * 64 + d0;
  const float* dec = (const float*)(p.ws + OFF_DEC) + (size_t)bhd * 68 * 64 + d0;
  float s[8];
#pragma unroll
  for (int k = 0; k < 8; ++k) s[k] = 0.f;
#pragma unroll 4
  for (int j = 0; j < 68; ++j) {
    const uint4 u = *(const uint4*)(base + (size_t)j * 8192);
    const float4 da = *(const float4*)(dec + j * 64), dbb = *(const float4*)(dec + j * 64 + 4);
#ifndef SCAN_NOSTORE
    if (j >= 4) {
      uint4 o; o.x = pack2(s[0], s[1]); o.y = pack2(s[2], s[3]); o.z = pack2(s[4], s[5]); o.w = pack2(s[6], s[7]);
      *(uint4*)(base + (size_t)j * 8192) = o;
    }
#endif
    s[0] = da.x * s[0] + lo_bf(u.x); s[1] = da.y * s[1] + hi_bf(u.x); s[2] = da.z * s[2] + lo_bf(u.y); s[3] = da.w * s[3] + hi_bf(u.y);
    s[4] = dbb.x * s[4] + lo_bf(u.z); s[5] = dbb.y * s[5] + hi_bf(u.z); s[6] = dbb.z * s[6] + lo_bf(u.w); s[7] = dbb.w * s[7] + hi_bf(u.w);
  }
#ifdef SCAN_NOSTORE
  { float* o = p.out + ((size_t)bhd * 128 + e) * 64 + d0;
#pragma unroll
    for (int k = 0; k < 8; ++k) o[k] = s[k]; }
#endif
}

__device__ __forceinline__ void gla_out_item(const Params& p, int b, int h, int n, const bf16_t* __restrict__ pb, bf16_t* __restrict__ mix, char* smem) {
  const int rbase = b * 4096 + n * 64;
  const bf16_t* qe = (const bf16_t*)(smem + 17408);
  const bf16_t* kinv = (const bf16_t*)(smem + 26624);
  bf16_t* att = (bf16_t*)(smem + 35840);
  const bf16_t* vT = (const bf16_t*)(smem + 45056);
  int tid_ = threadIdx.x;
  asm volatile("" : "+v"(tid_));
  const int lane = tid_ & 63, wv = tid_ >> 6, fr = lane & 15, fq = lane >> 4;
  f32x4 o[8];
#pragma unroll
  for (int jn = 0; jn < 8; ++jn) o[jn] = (f32x4){0.f, 0.f, 0.f, 0.f};
  gla_stage_vT(pb, rbase, h, smem);
#pragma unroll 1
  for (int dir = 0; dir < 2; ++dir) {
    gla_prep<true, true, false>(p, pb, rbase, h, dir, n, smem, nullptr);
    __syncthreads();
    f32x4 a4[4];
#pragma unroll
    for (int jn = 0; jn < 4; ++jn) a4[jn] = (f32x4){0.f, 0.f, 0.f, 0.f};
    wave_mma_lds<4>(qe + wv * 16 * LDK, kinv, a4, fr, fq);
    const int row = wv * 16 + fr;
#pragma unroll
    for (int jn = 0; jn < 4; ++jn) {
      float v[4];
#pragma unroll
      for (int r = 0; r < 4; ++r) {
        const int col = jn * 16 + fq * 4 + r;
        const bool keep = dir ? (col >= row) : (col <= row);
        v[r] = keep ? a4[jn][r] : 0.f;
      }
      uint2 pk; pk.x = pack2(v[0], v[1]); pk.y = pack2(v[2], v[3]);
      *(uint2*)(att + row * LDK + jn * 16 + fq * 4) = pk;
    }
    __syncthreads();
    wave_mma_lds<8>(att + wv * 16 * LDK, vT, o, fr, fq);
    const int jj = dir ? 63 - n : n;
    const bf16_t* ST = (const bf16_t*)(p.ws + OFF_EXTRA) + (size_t)(((b * 4 + h) * 2 + dir) * 68 + 4 + jj) * 8192;
    wave_mma_glb<8>(qe + wv * 16 * LDK, ST, o, fr, fq);
    __syncthreads();
  }
  float ss = 0.f;
#pragma unroll
  for (int jn = 0; jn < 8; ++jn) ss += o[jn][0] * o[jn][0] + o[jn][1] * o[jn][1] + o[jn][2] * o[jn][2] + o[jn][3] * o[jn][3];
  ss += __shfl_xor(ss, 16);
  ss += __shfl_xor(ss, 32);
  const float rstd = rsqrtf(ss * (1.f / 128.f) + 1e-6f);
  const int trow = rbase + wv * 16 + fr;
#pragma unroll
  for (int jn = 0; jn < 8; ++jn) {
    const int e = jn * 16 + fq * 4;
    const uint2 gq = *(const uint2*)(pb + (size_t)trow * NIN1P + 1536 + h * 128 + e);
    const float4 hw = *(const float4*)(p.cd_head_norm_w + e);
    const float y0 = o[jn][0] * rstd * hw.x * siluf_(lo_bf(gq.x)), y1 = o[jn][1] * rstd * hw.y * siluf_(hi_bf(gq.x));
    const float y2 = o[jn][2] * rstd * hw.z * siluf_(lo_bf(gq.y)), y3 = o[jn][3] * rstd * hw.w * siluf_(hi_bf(gq.y));
    uint2 pk; pk.x = pack2(y0, y1); pk.y = pack2(y2, y3);
    *(uint2*)(mix + (size_t)trow * 1024 + 512 + h * 128 + e) = pk;
  }
}

__device__ __forceinline__ void fft1_item(const Params& p, int b, int g, int t2, const bf16_t* __restrict__ pb, char* smem) {
  bf16_t* GT = (bf16_t*)smem;
  const bf16_t* T1 = (const bf16_t*)(p.ws + OFF_TAB + 65536);
  const bf16_t* C64 = T1 + 32768;
  const bf16_t* S64 = C64 + 4096;
  const bf16_t* NS64 = C64 + 8192;
  const float* tab = (const float*)(p.ws + OFF_TAB);
  int tid = threadIdx.x;
  asm volatile("" : "+v"(tid));
  const int lane = tid & 63, wv = tid >> 6, fr = lane & 15, fq = lane >> 4;
  {
    f32x4 ga[16];
#pragma unroll
    for (int j = 0; j < 16; ++j) ga[j] = (f32x4){0.f, 0.f, 0.f, 0.f};
    const bf16_t* frow = pb + (size_t)(b * 4096 + (wv * 16 + fr) * 64 + t2) * NIN1P + g * 128 + fq * 8;
#pragma unroll
    for (int s4 = 0; s4 < 4; ++s4) {
      const bf16x8 af = *(const bf16x8*)(frow + s4 * 32);
#pragma unroll
      for (int j = 0; j < 16; ++j) {
        const bf16x8 bfr = *(const bf16x8*)(T1 + (j * 16 + fr) * 128 + s4 * 32 + fq * 8);
        ga[j] = __builtin_amdgcn_mfma_f32_16x16x32_bf16(bfr, af, ga[j], 0, 0, 0);
      }
    }
#pragma unroll
    for (int j = 0; j < 16; ++j)
#pragma unroll
      for (int r = 0; r < 4; ++r) GT[(j * 16 + fq * 4 + r) * LDK + wv * 16 + fr] = f2bf(ga[j][r]);
  }
  __syncthreads();
  {
    f32x4 ar[8], ai[8];
#pragma unroll
    for (int j = 0; j < 8; ++j) { ar[j] = (f32x4){0.f, 0.f, 0.f, 0.f}; ai[j] = (f32x4){0.f, 0.f, 0.f, 0.f}; }
    const int k1 = wv * 16 + fr;
#pragma unroll
    for (int s2 = 0; s2 < 2; ++s2) {
      const bf16x8 cf = *(const bf16x8*)(C64 + k1 * 64 + s2 * 32 + fq * 8);
      const bf16x8 sf = *(const bf16x8*)(S64 + k1 * 64 + s2 * 32 + fq * 8);
      const bf16x8 nsf = *(const bf16x8*)(NS64 + k1 * 64 + s2 * 32 + fq * 8);
#pragma unroll
      for (int j = 0; j < 8; ++j) {
        const bf16x8 grf = *(const bf16x8*)(GT + (j * 16 + fr) * LDK + s2 * 32 + fq * 8);
        const bf16x8 gif = *(const bf16x8*)(GT + (128 + j * 16 + fr) * LDK + s2 * 32 + fq * 8);
        ar[j] = __builtin_amdgcn_mfma_f32_16x16x32_bf16(grf, cf, ar[j], 0, 0, 0);
        ar[j] = __builtin_amdgcn_mfma_f32_16x16x32_bf16(gif, sf, ar[j], 0, 0, 0);
        ai[j] = __builtin_amdgcn_mfma_f32_16x16x32_bf16(gif, cf, ai[j], 0, 0, 0);
        ai[j] = __builtin_amdgcn_mfma_f32_16x16x32_bf16(grf, nsf, ai[j], 0, 0, 0);
      }
    }
    const int tw = k1 * t2;
    const float tc = tab[384 + tw], ts = tab[4480 + tw];
    bf16_t* apr = (bf16_t*)p.out + ((size_t)((b * 4 + g) * 64 + k1) * 64 + t2) * 128;
    bf16_t* api = apr + 16777216;
#pragma unroll
    for (int j = 0; j < 8; ++j) {
      uint2 pr, pi;
      pr.x = pack2(ar[j][0] * tc + ai[j][0] * ts, ar[j][1] * tc + ai[j][1] * ts);
      pr.y = pack2(ar[j][2] * tc + ai[j][2] * ts, ar[j][3] * tc + ai[j][3] * ts);
      pi.x = pack2(ai[j][0] * tc - ar[j][0] * ts, ai[j][1] * tc - ar[j][1] * ts);
      pi.y = pack2(ai[j][2] * tc - ar[j][2] * ts, ai[j][3] * tc - ar[j][3] * ts);
      *(uint2*)(apr + j * 16 + fq * 4) = pr;
      *(uint2*)(api + j * 16 + fq * 4) = pi;
    }
  }
  __syncthreads();
}

__device__ __forceinline__ void fft2_item(const Params& p, int b, int g, int k1, bf16_t* __restrict__ mix, char* smem) {
  bf16_t* ArT = (bf16_t*)smem;
  bf16_t* AiT = ArT + 128 * LDK;
  const bf16_t* C64 = (const bf16_t*)(p.ws + OFF_TAB + 65536) + 32768;
  const bf16_t* S64 = C64 + 4096;
  const bf16_t* apr = (const bf16_t*)p.out + (size_t)((b * 4 + g) * 64 + k1) * 64 * 128;
  const bf16_t* api = apr + 16777216;
  int tid = threadIdx.x;
  asm volatile("" : "+v"(tid));
#pragma unroll
  for (int i = 0; i < 4; ++i) {
    const int idx = tid + i * 256, t2 = idx & 63, m8 = idx >> 6;
    const uint4 u = *(const uint4*)(apr + t2 * 128 + m8 * 8);
    const uint4 v = *(const uint4*)(api + t2 * 128 + m8 * 8);
    bf16_t* dr = ArT + (m8 * 8) * LDK + t2;
    bf16_t* di = AiT + (m8 * 8) * LDK + t2;
    dr[0 * LDK] = (bf16_t)(u.x & 0xffff); dr[1 * LDK] = (bf16_t)(u.x >> 16); dr[2 * LDK] = (bf16_t)(u.y & 0xffff); dr[3 * LDK] = (bf16_t)(u.y >> 16);
    dr[4 * LDK] = (bf16_t)(u.z & 0xffff); dr[5 * LDK] = (bf16_t)(u.z >> 16); dr[6 * LDK] = (bf16_t)(u.w & 0xffff); dr[7 * LDK] = (bf16_t)(u.w >> 16);
    di[0 * LDK] = (bf16_t)(v.x & 0xffff); di[1 * LDK] = (bf16_t)(v.x >> 16); di[2 * LDK] = (bf16_t)(v.y & 0xffff); di[3 * LDK] = (bf16_t)(v.y >> 16);
    di[4 * LDK] = (bf16_t)(v.z & 0xffff); di[5 * LDK] = (bf16_t)(v.z >> 16); di[6 * LDK] = (bf16_t)(v.w & 0xffff); di[7 * LDK] = (bf16_t)(v.w >> 16);
  }
  __syncthreads();
  const int lane = tid & 63, wv = tid >> 6, fr = lane & 15, fq = lane >> 4;
  const int k2 = wv * 16 + fr;
  f32x4 x[8];
#pragma unroll
  for (int j = 0; j < 8; ++j) x[j] = (f32x4){0.f, 0.f, 0.f, 0.f};
#pragma unroll
  for (int s2 = 0; s2 < 2; ++s2) {
    const bf16x8 cf = *(const bf16x8*)(C64 + k2 * 64 + s2 * 32 + fq * 8);
    const bf16x8 sf = *(const bf16x8*)(S64 + k2 * 64 + s2 * 32 + fq * 8);
#pragma unroll
    for (int j = 0; j < 8; ++j) {
      const bf16x8 rf = *(const bf16x8*)(ArT + (j * 16 + fr) * LDK + s2 * 32 + fq * 8);
      const bf16x8 jf = *(const bf16x8*)(AiT + (j * 16 + fr) * LDK + s2 * 32 + fq * 8);
      x[j] = __builtin_amdgcn_mfma_f32_16x16x32_bf16(rf, cf, x[j], 0, 0, 0);
      x[j] = __builtin_amdgcn_mfma_f32_16x16x32_bf16(jf, sf, x[j], 0, 0, 0);
    }
  }
  const float scale = 0.0013810679320049757f;
  bf16_t* orow = mix + (size_t)(b * 4096 + k1 + 64 * k2) * 1024 + g * 128;
#pragma unroll
  for (int j = 0; j < 8; ++j) {
    uint2 pk; pk.x = pack2(x[j][0] * scale, x[j][1] * scale); pk.y = pack2(x[j][2] * scale, x[j][3] * scale);
    *(uint2*)(orow + j * 16 + fq * 4) = pk;
  }
  __syncthreads();
}

__device__ __forceinline__ void phase_mix1a(const Params& p, char* smem) {
  const bf16_t* pb = (const bf16_t*)(p.ws + OFF_BIG);
  const int n_kv = 64 * 68, n_f1 = 8 * 4 * 64;
  for (int it = blockIdx.x; it < n_kv + n_f1; it += gridDim.x) {
    if (it < n_kv) { const int bhd = it / 68, j = it % 68; gla_kv_item(p, bhd >> 3, (bhd >> 1) & 3, bhd & 1, j, pb, smem); }
    else { int t = it - n_kv; fft1_item(p, t >> 8, (t >> 6) & 3, t & 63, pb, smem); }
  }
}

__device__ __forceinline__ void phase_mix1b(const Params& p, char* smem) {
  bf16_t* mix = (bf16_t*)(p.ws + OFF_HM);
  const int n_scan = 256, n_f2 = 8 * 4 * 64;
  for (int it = blockIdx.x; it < n_scan + n_f2; it += gridDim.x) {
#ifndef NO_SCAN
    if (it < n_scan) gla_scan_item(p, it >> 2, it & 3); else
#endif
    { int t = it - n_scan; if (t >= 0) fft2_item(p, t >> 8, (t >> 6) & 3, t & 63, mix, smem); }
  }
}

__device__ __forceinline__ void phase_mix1c(const Params& p, char* smem) {
  const bf16_t* pb = (const bf16_t*)(p.ws + OFF_BIG);
  bf16_t* mix = (bf16_t*)(p.ws + OFF_HM);
  for (int it = blockIdx.x; it < 2048; it += gridDim.x) gla_out_item(p, it >> 8, (it >> 6) & 3, it & 63, pb, mix, smem);
}

#ifndef STOP_AFTER
#define STOP_AFTER 107
#define DUMP_OB 1.0f
#define DUMP_AP 0.0f
#endif
__device__ __forceinline__ void dump_bf16(const bf16_t* buf, int ld, int ncols, float* out) {
  for (size_t idx = (size_t)blockIdx.x * NT + threadIdx.x; idx < (size_t)ROWS_L * 1024; idx += (size_t)gridDim.x * NT) {
    const int r = (int)(idx >> 10), c = (int)(idx & 1023);
    float s = 0.f;
    for (int cc = c; cc < ncols; cc += 1024) {
      s += bf2f(buf[(size_t)r * ld + cc]);
      if (r < ROWS_C) s += bf2f(buf[(size_t)(r + ROWS_L) * ld + cc]);
    }
    out[idx] = s;
  }
}
__device__ __forceinline__ void dump_f32(const float* buf, float* out) {
  for (size_t idx = (size_t)blockIdx.x * NT + threadIdx.x; idx < (size_t)ROWS_L * 1024; idx += (size_t)gridDim.x * NT) {
    const int r = (int)(idx >> 10);
    float s = buf[idx];
    if (r < ROWS_C) s += buf[idx + (size_t)ROWS_L * 1024];
    out[idx] = s;
  }
}

#define XB_XCNT(j) (256 + 64 * (j))
#define XB_XSUB(j) (1280 + 64 * (j))
#define XB_XGEN(j) (2304 + 64 * (j))
#define XB_TOP 3328
#define XB_TOPGEN 3392
struct BarState { unsigned x, nloc, nx; };
__device__ __forceinline__ unsigned xb_ld(unsigned* p) { return __hip_atomic_load(p, __ATOMIC_RELAXED, __HIP_MEMORY_SCOPE_AGENT); }
__device__ __forceinline__ unsigned xb_add(unsigned* p, unsigned v) { return __hip_atomic_fetch_add(p, v, __ATOMIC_RELAXED, __HIP_MEMORY_SCOPE_AGENT); }
__device__ __forceinline__ void grid_barrier_post(unsigned* bar, BarState& st) {
  st.x = (unsigned)__builtin_amdgcn_s_getreg((3 << 11) | 20) & 0xFu;
  st.nloc = 0u; st.nx = 0u;
  if (threadIdx.x == 0) (void)xb_add(&bar[XB_XCNT(st.x)], 1u);
}
__device__ __forceinline__ void grid_barrier(unsigned* bar, BarState& st, const float*, float*) {
  asm volatile("s_waitcnt vmcnt(0) lgkmcnt(0)" ::: "memory");
  __syncthreads();
  if (threadIdx.x == 0) {
    if (st.nloc == 0u) {
      const unsigned G = gridDim.x;
      for (;;) {
        unsigned sum = 0u, cnt = 0u, mine = 0u;
#pragma unroll
        for (unsigned j = 0; j < 16; ++j) { const unsigned c = xb_ld(&bar[XB_XCNT(j)]); sum += c; cnt += (c > 0u) ? 1u : 0u; mine = (j == st.x) ? c : mine; }
        if (sum == G) { st.nloc = mine; st.nx = cnt; break; }
        __builtin_amdgcn_s_sleep(1);
      }
    }
    const unsigned old = xb_add(&bar[XB_XSUB(st.x)], 1u);
    const unsigned gen = old / st.nloc;
    if (old + 1u == (gen + 1u) * st.nloc) {
      __builtin_amdgcn_fence(__ATOMIC_RELEASE, "agent");
      asm volatile("s_waitcnt vmcnt(0)" ::: "memory");
      const unsigned og = xb_add(&bar[XB_TOP], 1u);
      const unsigned tg = og / st.nx;
      if (og + 1u == (tg + 1u) * st.nx) (void)xb_add(&bar[XB_TOPGEN], 1u);
      else while (xb_ld(&bar[XB_TOPGEN]) == tg) __builtin_amdgcn_s_sleep(1);
      __builtin_amdgcn_fence(__ATOMIC_ACQUIRE, "agent");
      (void)xb_add(&bar[XB_XGEN(st.x)], 1u);
      asm volatile("s_waitcnt vmcnt(0)" ::: "memory");
    } else {
      while (xb_ld(&bar[XB_XGEN(st.x)]) == gen) __builtin_amdgcn_s_sleep(1);
      __builtin_amdgcn_fence(__ATOMIC_ACQUIRE, "agent");
      asm volatile("s_waitcnt vmcnt(0)" ::: "memory");
    }
  }
  __syncthreads();
}

constexpr int NPHASE = 16;
#ifndef ONLY
#define ONLY -1
#endif
#define PH_EN(n) (ONLY < 0 || ONLY == (n))

template <int PH>
__device__ __forceinline__ void run_phase(const Params& p, char* smem) {
  const float* mod0 = (const float*)(p.ws + OFF_MOD);
  const float* mod1 = mod0 + 9 * MODN;
  float* xres = (float*)(p.ws + OFF_XRES);
  float* xctx = xres + (size_t)ROWS_L * 1024;
  bf16_t* hm = (bf16_t*)(p.ws + OFF_HM);
  bf16_t* big = (bf16_t*)(p.ws + OFF_BIG);
  if (PH == 0) phase_prep(p, smem);
  if (PH == 1) phase_norm(p.x, p.ctx, p.norm_mix_w, mod0, 0, 1024, hm, ROWS);
  if (PH == 2) { Epi e{}; e.C = big; e.ldc = NIN0; e.gelu_cols = 1024;
    gemm_phase<0>(hm, 1024, (const bf16_t*)(p.ws + OFF_WIN0), 1024, ROWS, NIN0, smem, e); }
  if (PH == 3) phase_mix0(p, smem);
  if (PH == 4) { Epi e{}; e.src_lat = p.x; e.src_ctx = p.ctx; e.dst = xres; e.gate = mod0 + 2048;
    gemm_phase<1>(hm, 1024, (const bf16_t*)(p.ws + OFF_WOUT0), 1024, ROWS, 1024, smem, e); }
  if (PH == 5) phase_norm(xres, xctx, p.norm_ffn_w, mod0, 3072, 4096, hm, ROWS);
  if (PH == 6) { Epi e{}; e.C = big; e.ldc = FFN;
    gemm_phase<2>(hm, 1024, (const bf16_t*)(p.ws + OFF_WGU0), 1024, ROWS, 2 * FFN, smem, e); }
  if (PH == 7) { Epi e{}; e.src_lat = xres; e.src_ctx = xctx; e.dst = xres; e.gate = mod0 + 5120;
    gemm_phase<1>(big, FFN, (const bf16_t*)(p.ws + OFF_WD0), FFN, ROWS, 1024, smem, e); }
  if (PH == 8) phase_norm(xres, xctx, p.norm_mix_w + 1024, mod1, 0, 1024, hm, ROWS);
  if (PH == 9) { Epi e{}; e.C = big; e.ldc = NIN1P; e.gelu_cols = 0;
    gemm_phase<0>(hm, 1024, (const bf16_t*)(p.ws + OFF_WIN1), 1024, ROWS, NIN1P, smem, e); }
  if (PH == 10) phase_mix1a(p, smem);
  if (PH == 11) phase_mix1b(p, smem);
  if (PH == 12) phase_mix1c(p, smem);
  if (PH == 13) { Epi e{}; e.src_lat = xres; e.src_ctx = xctx; e.dst = xres; e.gate = mod1 + 2048;
    gemm_phase<1>(hm, 1024, (const bf16_t*)(p.ws + OFF_WOUT1), 1024, ROWS_L, 1024, smem, e); }
  if (PH == 14) phase_norm(xres, xctx, p.norm_ffn_w + 1024, mod1, 3072, 4096, hm, ROWS_L);
  if (PH == 15) { Epi e{}; e.C = big; e.ldc = FFN;
    gemm_phase<2>(hm, 1024, (const bf16_t*)(p.ws + OFF_WGU1), 1024, ROWS_L, 2 * FFN, smem, e); }
  if (PH == 16) { Epi e{}; e.src_lat = xres; e.src_ctx = xctx; e.dst = xres; e.gate = mod1 + 5120;
    gemm_phase<1>(big, FFN, (const bf16_t*)(p.ws + OFF_WD1), FFN, ROWS_L, 1024, smem, e); }
  if (PH == 17) phase_final_norm(xres, p.final_norm_w, p.out);
}
constexpr int NPH = 18;

#ifndef MULTI_LAUNCH
#define MULTI_LAUNCH 0
#endif

#if MULTI_LAUNCH
template <int PH>
__global__ void __launch_bounds__(NT, 2) phase_kernel(Params p) {
  __shared__ __attribute__((aligned(16))) char smem[65536];
  run_phase<PH>(p, smem);
}
template <int PH>
static void launch_phases(const Params& p, int grid, hipStream_t stream) {
  phase_kernel<PH><<<dim3(grid), dim3(NT), 0, stream>>>(p);
  if constexpr (PH + 1 < NPH) launch_phases<PH + 1>(p, grid, stream);
}
#else
template <int PH>
__device__ __forceinline__ void run_all(const Params& p, char* smem, unsigned* bar, BarState& gen) {
  run_phase<PH>(p, smem);
#ifdef DOUBLE_MASK
  if constexpr ((DOUBLE_MASK >> PH) & 1) { grid_barrier(bar, gen, p.x, p.out); run_phase<PH>(p, smem); }
#endif
  if constexpr (PH + 1 < NPH) { grid_barrier(bar, gen, p.x, p.out); run_all<PH + 1>(p, smem, bar, gen); }
}
__global__ void __launch_bounds__(NT, 2) fwd_kernel(Params p) {
  __shared__ __attribute__((aligned(16))) char smem[65536];
  unsigned* bar = (unsigned*)(p.ws + OFF_BAR);
  BarState gen;
  grid_barrier_post(bar, gen);
  run_all<0>(p, smem, bar, gen);
}
#endif

extern "C" void kernel_launch(void* const* d_in, const int* in_sizes, int n_in, void* d_out, int out_size, void* d_ws, size_t ws_size,
                              hipStream_t stream) {
  if (ws_size < WS_NEED) { fprintf(stderr, "workspace too small: %zu\n", ws_size); return; }
  Params p{};
  const float** pp = (const float**)&p;
  for (int i = 0; i < 25; ++i) pp[i] = (const float*)d_in[i];
  p.out = (float*)d_out;
  p.ws = (char*)d_ws;
#if MULTI_LAUNCH
  launch_phases<0>(p, 512, stream);
#else
  static int grid_blocks = 0;
  if (!grid_blocks) {
    int dev = 0, cus = 0, per_cu = 0;
    (void)hipGetDevice(&dev);
    (void)hipDeviceGetAttribute(&cus, hipDeviceAttributeMultiprocessorCount, dev);
    (void)hipOccupancyMaxActiveBlocksPerMultiprocessor(&per_cu, fwd_kernel, NT, 0);
    if (per_cu > 2) per_cu = 2;
    if (per_cu < 1) per_cu = 1;
    grid_blocks = cus * per_cu;
  }
  (void)hipMemsetAsync((char*)d_ws + OFF_BAR, 0, 16384, stream);
  void* args[] = {&p};
  hipError_t err = hipLaunchCooperativeKernel((void*)fwd_kernel, dim3(grid_blocks), dim3(NT), args, 0, stream);
  if (err != hipSuccess) fprintf(stderr, "cooperative launch failed: %s (grid %d)\n", hipGetErrorString(err), grid_blocks);
#endif
}
```

```cpp
#include <hip/hip_runtime.h>
#include <hip/hip_cooperative_groups.h>
#include <cstdio>
namespace cg = cooperative_groups;

typedef unsigned short bf16_t;
typedef short bf16x8 __attribute__((ext_vector_type(8)));
typedef float f32x4 __attribute__((ext_vector_type(4)));

#define NT 256
constexpr int D = 1024, SEQ = 4096, NB = 8, CTXL = 256;
constexpr int ROWS_L = NB * SEQ;
constexpr int ROWS_C = NB * CTXL;
constexpr int ROWS = ROWS_L + ROWS_C;
constexpr int FFN = 2816;
constexpr int NIN0 = 2560, NIN1 = 2080, NIN1P = 2176;
constexpr int MODN = 6144;
constexpr int LDK = 72;

constexpr size_t MiB = (size_t)1 << 20;
constexpr size_t OFF_WIN0 = 0, OFF_WOUT0 = 5 * MiB, OFF_WGU0 = 7 * MiB, OFF_WD0 = 18 * MiB;
constexpr size_t OFF_WIN1 = 24 * MiB, OFF_WOUT1 = 29 * MiB, OFF_WGU1 = 31 * MiB, OFF_WD1 = 42 * MiB;
constexpr size_t OFF_MOD = 48 * MiB;
constexpr size_t OFF_TAB = 48 * MiB + 512 * 1024;
constexpr size_t OFF_BAR = 48 * MiB + 768 * 1024;
constexpr size_t OFF_XRES = 49 * MiB;
constexpr size_t OFF_HM = 185 * MiB;
constexpr size_t OFF_BIG = 253 * MiB;
constexpr size_t OFF_APR = OFF_BIG + 145 * MiB;
constexpr size_t OFF_API = OFF_BIG + 161 * MiB;
constexpr size_t OFF_EXTRA = 440 * MiB;
constexpr size_t WS_NEED = 508 * MiB;

struct Params {
  const float *x, *c, *ctx, *c_ctx, *ada_w, *ada_b, *norm_mix_w, *norm_ffn_w, *ffn_w_gate, *ffn_w_up, *ffn_w_down;
  const float *ab_w_in, *ab_w_out, *ab_sgu_norm_w, *ab_sgu_w, *ab_sgu_b, *ab_rel_bias;
  const float *cd_w_in, *cd_w_out, *cd_dw_f, *cd_db_f, *cd_dw_b, *cd_db_b, *cd_head_norm_w, *final_norm_w;
  float* out;
  char* ws;
};

__device__ __forceinline__ bf16_t f2bf(float f) {
  unsigned u = __float_as_uint(f);
  u += 0x7fffu + ((u >> 16) & 1u);
  return (bf16_t)(u >> 16);
}
__device__ __forceinline__ float bf2f(bf16_t h) { return __uint_as_float(((unsigned)h) << 16); }
__device__ __forceinline__ unsigned pack2(float a, float b) { return (unsigned)f2bf(a) | ((unsigned)f2bf(b) << 16); }
__device__ __forceinline__ float lo_bf(unsigned u) { return __uint_as_float(u << 16); }
__device__ __forceinline__ float hi_bf(unsigned u) { return __uint_as_float(u & 0xffff0000u); }
__device__ __forceinline__ float sigmoidf_(float x) { return 1.f / (1.f + __expf(-x)); }
__device__ __forceinline__ float siluf_(float x) { return x * sigmoidf_(x); }
__device__ __forceinline__ float geluf_(float x) {
  float u = 0.7978845608028654f * (x + 0.044715f * x * x * x);
  return x * sigmoidf_(2.f * u);
}
__device__ __forceinline__ float wave_sum(float v) {
#pragma unroll
  for (int o = 32; o > 0; o >>= 1) v += __shfl_xor(v, o);
  return v;
}
__device__ __forceinline__ float cos_rev(float r) { return __builtin_amdgcn_cosf(r); }
__device__ __forceinline__ float sin_rev(float r) { return __builtin_amdgcn_sinf(r); }

__device__ __forceinline__ void wt_tile(const float* __restrict__ src, const float* __restrict__ src2, int N, int ldsrc, bf16_t* __restrict__ dst,
                        int lddst, int kt, int ntile, int mode, float* tile) {
  const int tid = threadIdx.x;
#pragma unroll
  for (int i = 0; i < 4; ++i) {
    const int kk = (tid >> 4) + i * 16, j4 = (tid & 15) * 4;
    float4 v = make_float4(0.f, 0.f, 0.f, 0.f);
    if (mode == 0) {
      const int col = ntile * 64 + j4;
      if (col < N) v = *(const float4*)(src + (size_t)(kt * 64 + kk) * ldsrc + col);
    } else {
      const int col = ntile * 32 + (j4 & 31);
      const float* sp = (j4 < 32) ? src : src2;
      v = *(const float4*)(sp + (size_t)(kt * 64 + kk) * ldsrc + col);
    }
    tile[(j4 + 0) * 65 + kk] = v.x; tile[(j4 + 1) * 65 + kk] = v.y; tile[(j4 + 2) * 65 + kk] = v.z; tile[(j4 + 3) * 65 + kk] = v.w;
  }
  __syncthreads();
#pragma unroll
  for (int i = 0; i < 2; ++i) {
    const int e = tid + i * 256, j = e >> 3, k8 = (e & 7) * 8;
    const float* tp = tile + j * 65 + k8;
    uint4 pk; pk.x = pack2(tp[0], tp[1]); pk.y = pack2(tp[2], tp[3]); pk.z = pack2(tp[4], tp[5]); pk.w = pack2(tp[6], tp[7]);
    *(uint4*)(dst + (size_t)(ntile * 64 + j) * lddst + kt * 64 + k8) = pk;
  }
  __syncthreads();
}

__device__ __forceinline__ void mod_item(const Params& p, int item, float* sm) {
  const int l = item / 96, cgp = item % 96;
  const int tid = threadIdx.x, nn = tid & 63, ks = tid >> 6;
  float* sil = sm;
  float* red = sm + 4 * 9 * 256;
  for (int e = tid; e < 9 * 1024; e += NT) {
    int v = e >> 10, k = e & 1023;
    float cv = (v < 8) ? p.c[v * 1024 + k] : p.c_ctx[k];
    sil[((k >> 8) * 9 + v) * 256 + (k & 255)] = siluf_(cv);
  }
  __syncthreads();
  float acc[9];
#pragma unroll
  for (int v = 0; v < 9; ++v) acc[v] = 0.f;
  const float* w = p.ada_w + (size_t)l * 1024 * MODN + cgp * 64 + nn;
#pragma unroll 16
  for (int k = 0; k < 256; ++k) {
    float wv = w[(size_t)(ks * 256 + k) * MODN];
#pragma unroll
    for (int v = 0; v < 9; ++v) acc[v] += sil[(ks * 9 + v) * 256 + k] * wv;
  }
#pragma unroll
  for (int v = 0; v < 9; ++v) red[(ks * 9 + v) * 64 + nn] = acc[v];
  __syncthreads();
  float* mod = (float*)(p.ws + OFF_MOD);
  for (int e = tid; e < 9 * 64; e += NT) {
    int v = e >> 6, n = e & 63;
    float s = red[(0 * 9 + v) * 64 + n] + red[(1 * 9 + v) * 64 + n] + red[(2 * 9 + v) * 64 + n] + red[(3 * 9 + v) * 64 + n];
    mod[((size_t)l * 9 + v) * MODN + cgp * 64 + n] = s + p.ada_b[l * MODN + cgp * 64 + n];
  }
  __syncthreads();
}

__device__ __forceinline__ void phase_prep(const Params& p, char* smem) {
  float* sm = (float*)smem;
  bf16_t* W = (bf16_t*)p.ws;
  const int n_in0 = 16 * 40, n_out = 16 * 16, n_gu = 16 * 88, n_d = 44 * 16, n_in1 = 16 * 34;
  const int c0 = n_in0, c1 = c0 + n_out, c2 = c1 + n_gu, c3 = c2 + n_d, c4 = c3 + n_in1, c5 = c4 + n_out, c6 = c5 + n_gu, c7 = c6 + n_d;
  const int total = c7 + 192 + 1;
  for (int it = blockIdx.x; it < total; it += gridDim.x) {
    if (it < c0) { int t = it; wt_tile(p.ab_w_in, nullptr, NIN0, NIN0, (bf16_t*)(p.ws + OFF_WIN0), 1024, t / 40, t % 40, 0, sm); }
    else if (it < c1) { int t = it - c0; wt_tile(p.ab_w_out, nullptr, 1024, 1024, (bf16_t*)(p.ws + OFF_WOUT0), 1024, t / 16, t % 16, 0, sm); }
    else if (it < c2) { int t = it - c1; wt_tile(p.ffn_w_gate, p.ffn_w_up, FFN, FFN, (bf16_t*)(p.ws + OFF_WGU0), 1024, t / 88, t % 88, 1, sm); }
    else if (it < c3) { int t = it - c2; wt_tile(p.ffn_w_down, nullptr, 1024, 1024, (bf16_t*)(p.ws + OFF_WD0), FFN, t / 16, t % 16, 0, sm); }
    else if (it < c4) { int t = it - c3; wt_tile(p.cd_w_in, nullptr, NIN1, NIN1, (bf16_t*)(p.ws + OFF_WIN1), 1024, t / 34, t % 34, 0, sm); }
    else if (it < c5) { int t = it - c4; wt_tile(p.cd_w_out, nullptr, 1024, 1024, (bf16_t*)(p.ws + OFF_WOUT1), 1024, t / 16, t % 16, 0, sm); }
    else if (it < c6) { int t = it - c5; wt_tile(p.ffn_w_gate + (size_t)1024 * FFN, p.ffn_w_up + (size_t)1024 * FFN, FFN, FFN, (bf16_t*)(p.ws + OFF_WGU1), 1024, t / 88, t % 88, 1, sm); }
    else if (it < c7) { int t = it - c6; wt_tile(p.ffn_w_down + (size_t)FFN * 1024, nullptr, 1024, 1024, (bf16_t*)(p.ws + OFF_WD1), FFN, t / 16, t % 16, 0, sm); }
    else if (it < c7 + 192) { mod_item(p, it - c7, sm); }
    else {
      float* tab = (float*)(p.ws + OFF_TAB);
      for (int e = threadIdx.x; e < 128; e += NT) { tab[e] = cos_rev(e / 128.f); tab[128 + e] = sin_rev(e / 128.f); }
      for (int e = threadIdx.x; e < 64; e += NT) { tab[256 + e] = cos_rev(e / 64.f); tab[320 + e] = sin_rev(e / 64.f); }
      for (int e = threadIdx.x; e < 4096; e += NT) { tab[384 + e] = cos_rev(e / 4096.f); tab[4480 + e] = sin_rev(e / 4096.f); }
      for (int e = threadIdx.x; e < 1024; e += NT) {
        int pos = e >> 4, i = e & 15;
        float inv = __expf(-(float)i / 16.f * 9.210340371976184f);
        float ang = (float)pos * inv;
        float rev = ang * 0.15915494309189535f;
        rev = rev - floorf(rev);
        tab[8576 + e] = cos_rev(rev); tab[9600 + e] = sin_rev(rev);
      }
      bf16_t* t1 = (bf16_t*)(p.ws + OFF_TAB + 65536);
      for (int e = threadIdx.x; e < 32768; e += NT) {
        const int n = e >> 7, cidx = e & 127;
        const float rev = (float)((cidx * (n & 127)) & 127) / 128.f;
        t1[e] = f2bf(n < 128 ? cos_rev(rev) : -sin_rev(rev));
      }
      bf16_t* c64 = t1 + 32768;
      for (int e = threadIdx.x; e < 4096; e += NT) {
        const float rev = (float)(((e >> 6) * (e & 63)) & 63) / 64.f;
        const float cv = cos_rev(rev), sv = sin_rev(rev);
        c64[e] = f2bf(cv); c64[4096 + e] = f2bf(sv); c64[8192 + e] = f2bf(-sv);
      }
    }
  }
}

__device__ __forceinline__ void phase_norm(const float* __restrict__ src_lat, const float* __restrict__ src_ctx, const float* __restrict__ w,
                           const float* __restrict__ modl  , int sh_off, int sc_off, bf16_t* __restrict__ dst, int nrows) {
  const int lane = threadIdx.x & 63, wid = threadIdx.x >> 6;
  for (int r = blockIdx.x * 4 + wid; r < nrows; r += gridDim.x * 4) {
    const float* s = (r < ROWS_L) ? src_lat + (size_t)r * 1024 : src_ctx + (size_t)(r - ROWS_L) * 1024;
    const int vec = (r < ROWS_L) ? (r >> 12) : 8;
    const float* mv = modl + (size_t)vec * MODN;
    float4 v[4];
    float ss = 0.f;
#pragma unroll
    for (int i = 0; i < 4; ++i) {
      v[i] = *(const float4*)(s + i * 256 + lane * 4);
      ss += v[i].x * v[i].x + v[i].y * v[i].y + v[i].z * v[i].z + v[i].w * v[i].w;
    }
    ss = wave_sum(ss);
    const float rstd = rsqrtf(ss * (1.f / 1024.f) + 1e-6f);
#pragma unroll
    for (int i = 0; i < 4; ++i) {
      const int cidx = i * 256 + lane * 4;
      float4 wv = *(const float4*)(w + cidx);
      float4 sc = *(const float4*)(mv + sc_off + cidx);
      float4 sh = *(const float4*)(mv + sh_off + cidx);
      float o0 = v[i].x * rstd * wv.x * (1.f + sc.x) + sh.x;
      float o1 = v[i].y * rstd * wv.y * (1.f + sc.y) + sh.y;
      float o2 = v[i].z * rstd * wv.z * (1.f + sc.z) + sh.z;
      float o3 = v[i].w * rstd * wv.w * (1.f + sc.w) + sh.w;
      uint2 pk; pk.x = pack2(o0, o1); pk.y = pack2(o2, o3);
      *(uint2*)(dst + (size_t)r * 1024 + cidx) = pk;
    }
  }
}

__device__ __forceinline__ void phase_final_norm(const float* __restrict__ src, const float* __restrict__ w, float* __restrict__ dst) {
  const int lane = threadIdx.x & 63, wid = threadIdx.x >> 6;
  for (int r = blockIdx.x * 4 + wid; r < ROWS_L; r += gridDim.x * 4) {
    const float* s = src + (size_t)r * 1024;
    float4 v[4];
    float ss = 0.f;
#pragma unroll
    for (int i = 0; i < 4; ++i) {
      v[i] = *(const float4*)(s + i * 256 + lane * 4);
      ss += v[i].x * v[i].x + v[i].y * v[i].y + v[i].z * v[i].z + v[i].w * v[i].w;
    }
    ss = wave_sum(ss);
    const float rstd = rsqrtf(ss * (1.f / 1024.f) + 1e-6f);
#pragma unroll
    for (int i = 0; i < 4; ++i) {
      const int cidx = i * 256 + lane * 4;
      float4 wv = *(const float4*)(w + cidx);
      float4 o; o.x = v[i].x * rstd * wv.x; o.y = v[i].y * rstd * wv.y; o.z = v[i].z * rstd * wv.z; o.w = v[i].w * rstd * wv.w;
      *(float4*)(dst + (size_t)r * 1024 + cidx) = o;
    }
  }
}

struct Epi {
  bf16_t* C; int ldc; int gelu_cols;
  const float* src_lat; const float* src_ctx;
  float* dst;
  const float* gate;
};

template <int EPI, int IM>
__device__ __forceinline__ void gemm_tiles(const bf16_t* __restrict__ A, int lda, const bf16_t* __restrict__ Bt, int K, int mrow0, int Mrows, int N,
                           int blk_shift, char* smem, const Epi ep) {
  const int tid = threadIdx.x, lane = tid & 63, wid = tid >> 6, wm = wid >> 1, wn = wid & 1;
  const int fr = lane & 15, fq = lane >> 4;
  const int nMt = Mrows / (IM * 32), nNt = N / 128, ntiles = nMt * nNt, nk = K / 64;
  const int drow = lane >> 3, dkc = (lane & 7) ^ (lane >> 3);
  const int ko0 = ((fq) ^ (fr & 7)) * 16, ko1 = ((4 + fq) ^ (fr & 7)) * 16;
  const int vb0 = (int)(blockIdx.x & 7u) * (int)(gridDim.x >> 3) + (int)(blockIdx.x >> 3);
  const int vb = (vb0 + (int)gridDim.x - blk_shift) % (int)gridDim.x;
  for (int tile = vb; tile < ntiles; tile += gridDim.x) {
    const int grp = tile / (8 * nNt), wi = tile % (8 * nNt);
    const int mt = grp * 8 + (wi & 7), nt = wi >> 3;
    const int m0 = mrow0 + mt * (IM * 32), n0 = nt * 128;
    f32x4 acc[IM][4];
#pragma unroll
    for (int i = 0; i < IM; ++i)
#pragma unroll
      for (int j = 0; j < 4; ++j) acc[i][j] = (f32x4){0.f, 0.f, 0.f, 0.f};
    const bf16_t* gA = A + (size_t)(m0 + wid * (IM * 8) + drow) * lda + dkc * 8;
    const bf16_t* gB = Bt + (size_t)(n0 + wid * 32 + drow) * K + dkc * 8;
    auto dma_a = [&](int kt_) {
      char* sb_ = smem + lane * 16;
#pragma unroll
      for (int i = 0; i < IM; ++i)
        __builtin_amdgcn_global_load_lds((const unsigned*)(gA + (size_t)i * 8 * lda + kt_ * 64), (unsigned*)(sb_ + (wid * IM + i) * 1024), 16, 0, 0);
    };
    auto dma_b = [&](int kt_) {
      char* sb_ = smem + 32768 + (kt_ & 1) * 16384 + lane * 16;
#pragma unroll
      for (int i = 0; i < 4; ++i)
        __builtin_amdgcn_global_load_lds((const unsigned*)(gB + (size_t)i * 8 * K + kt_ * 64), (unsigned*)(sb_ + (wid * 4 + i) * 1024), 16, 0, 0);
    };
    const char* as = smem + (wm * (IM * 16) + fr) * 128;
    asm volatile("s_waitcnt vmcnt(0)" ::: "memory");
    __syncthreads();
    dma_a(0); dma_b(0);
    for (int kt = 0; kt < nk; ++kt) {
      asm volatile("s_waitcnt vmcnt(0)" ::: "memory");
      __builtin_amdgcn_s_barrier();
      asm volatile("" ::: "memory");
      if (kt + 1 < nk) dma_b(kt + 1);
      const char* bs = smem + 32768 + (kt & 1) * 16384 + (wn * 64 + fr) * 128;
      bf16x8 af[IM], bfr[4];
#pragma unroll
      for (int j = 0; j < 4; ++j) bfr[j] = *(const bf16x8*)(bs + j * 2048 + ko0);
#pragma unroll
      for (int i = 0; i < IM; ++i) af[i] = *(const bf16x8*)(as + i * 2048 + ko0);
      __builtin_amdgcn_sched_barrier(0);
#pragma unroll
      for (int i = 0; i < IM; ++i)
#pragma unroll
        for (int j = 0; j < 4; ++j) acc[i][j] = __builtin_amdgcn_mfma_f32_16x16x32_bf16(bfr[j], af[i], acc[i][j], 0, 0, 0);
      __builtin_amdgcn_sched_barrier(0);
#pragma unroll
      for (int j = 0; j < 4; ++j) bfr[j] = *(const bf16x8*)(bs + j * 2048 + ko1);
#pragma unroll
      for (int i = 0; i < IM; ++i) af[i] = *(const bf16x8*)(as + i * 2048 + ko1);
      __builtin_amdgcn_sched_barrier(0);
      asm volatile("s_waitcnt lgkmcnt(0)" ::: "memory");
      __builtin_amdgcn_s_barrier();
      asm volatile("" ::: "memory");
      if (kt + 1 < nk) dma_a(kt + 1);
      __builtin_amdgcn_sched_barrier(0);
#pragma unroll
      for (int i = 0; i < IM; ++i)
#pragma unroll
        for (int j = 0; j < 4; ++j) acc[i][j] = __builtin_amdgcn_mfma_f32_16x16x32_bf16(bfr[j], af[i], acc[i][j], 0, 0, 0);
      __builtin_amdgcn_sched_barrier(0);
    }
    if (EPI == 0) {
      const bool do_gelu = n0 < ep.gelu_cols;
#pragma unroll
      for (int i = 0; i < IM; ++i) {
        const int m = m0 + wm * (IM * 16) + i * 16 + fr;
#pragma unroll
        for (int j = 0; j < 4; ++j) {
          const int n = n0 + wn * 64 + j * 16 + fq * 4;
          f32x4 v = acc[i][j];
          if (do_gelu) { v[0] = geluf_(v[0]); v[1] = geluf_(v[1]); v[2] = geluf_(v[2]); v[3] = geluf_(v[3]); }
          uint2 pk; pk.x = pack2(v[0], v[1]); pk.y = pack2(v[2], v[3]);
          *(uint2*)(ep.C + (size_t)m * ep.ldc + n) = pk;
        }
      }
    } else if (EPI == 1) {
      const int vec = (m0 < ROWS_L) ? (m0 >> 12) : 8;
      const float* gv = ep.gate + (size_t)vec * MODN;
#pragma unroll
      for (int i = 0; i < IM; ++i) {
        const int m = m0 + wm * (IM * 16) + i * 16 + fr;
        const float* srow_p = (m < ROWS_L) ? ep.src_lat + (size_t)m * 1024 : ep.src_ctx + (size_t)(m - ROWS_L) * 1024;
#pragma unroll
        for (int j = 0; j < 4; ++j) {
          const int n = n0 + wn * 64 + j * 16 + fq * 4;
          float4 sv = *(const float4*)(srow_p + n);
          float4 g = *(const float4*)(gv + n);
          float4 o;
          o.x = sv.x + g.x * acc[i][j][0]; o.y = sv.y + g.y * acc[i][j][1];
          o.z = sv.z + g.z * acc[i][j][2]; o.w = sv.w + g.w * acc[i][j][3];
          *(float4*)(ep.dst + (size_t)m * 1024 + n) = o;
        }
      }
    } else {
#pragma unroll
      for (int i = 0; i < IM; ++i) {
        const int m = m0 + wm * (IM * 16) + i * 16 + fr;
#pragma unroll
        for (int j = 0; j < 2; ++j) {
          const int n = (n0 >> 1) + wn * 32 + j * 16 + fq * 4;
          f32x4 g = acc[i][j], u = acc[i][j + 2];
          uint2 pk;
          pk.x = pack2(siluf_(g[0]) * u[0], siluf_(g[1]) * u[1]);
          pk.y = pack2(siluf_(g[2]) * u[2], siluf_(g[3]) * u[3]);
          *(uint2*)(ep.C + (size_t)m * ep.ldc + n) = pk;
        }
      }
    }
  }
}


template <int EPI>
__device__ __forceinline__ void gemm_phase(const bf16_t* __restrict__ A, int lda, const bf16_t* __restrict__ Bt, int K, int Mrows, int N,
                           char* smem, const Epi ep) {
  gemm_tiles<EPI, 8>(A, lda, Bt, K, 0, ROWS_L, N, 0, smem, ep);
  if (Mrows > ROWS_L) {
    const int lat_tiles = (ROWS_L / 256) * (N / 128);
    gemm_tiles<EPI, 4>(A, lda, Bt, K, ROWS_L, Mrows - ROWS_L, N, lat_tiles % (int)gridDim.x, smem, ep);
  }
}

__device__ __forceinline__ void sgu_item(const Params& p, int ck, int g, const bf16_t* __restrict__ pb, bf16_t* __restrict__ mix, char* smem) {
  constexpr int LDV = 136;
  bf16_t* vnT = (bf16_t*)smem;
  int tid = threadIdx.x;
  asm volatile("" : "+v"(tid));
  const int r0 = ck * 128;
  {
    const int q = tid >> 1, half = tid & 1;
    const bf16_t* vrow = pb + (size_t)(r0 + q) * NIN0 + 512 + half * 256;
    float ss = 0.f;
#pragma unroll 4
    for (int i = 0; i < 32; ++i) {
      uint4 u = *(const uint4*)(vrow + i * 8);
      float a;
      a = lo_bf(u.x); ss += a * a; a = hi_bf(u.x); ss += a * a;
      a = lo_bf(u.y); ss += a * a; a = hi_bf(u.y); ss += a * a;
      a = lo_bf(u.z); ss += a * a; a = hi_bf(u.z); ss += a * a;
      a = lo_bf(u.w); ss += a * a; a = hi_bf(u.w); ss += a * a;
    }
    ss += __shfl_xor(ss, 1);
    const float rstd = rsqrtf(ss * (1.f / 512.f) + 1e-6f);
    const bf16_t* vg = pb + (size_t)(r0 + q) * NIN0 + 512 + g * 128 + half * 64;
    const float* nw = p.ab_sgu_norm_w + g * 128 + half * 64;
#pragma unroll 2
    for (int i = 0; i < 8; ++i) {
      const uint4 u = *(const uint4*)(vg + i * 8);
      const float4 w0 = *(const float4*)(nw + i * 8), w1 = *(const float4*)(nw + i * 8 + 4);
      bf16_t* dp = vnT + (half * 64 + i * 8) * LDV + q;
      dp[0 * LDV] = f2bf(lo_bf(u.x) * rstd * w0.x); dp[1 * LDV] = f2bf(hi_bf(u.x) * rstd * w0.y);
      dp[2 * LDV] = f2bf(lo_bf(u.y) * rstd * w0.z); dp[3 * LDV] = f2bf(hi_bf(u.y) * rstd * w0.w);
      dp[4 * LDV] = f2bf(lo_bf(u.z) * rstd * w1.x); dp[5 * LDV] = f2bf(hi_bf(u.z) * rstd * w1.y);
      dp[6 * LDV] = f2bf(lo_bf(u.w) * rstd * w1.z); dp[7 * LDV] = f2bf(hi_bf(u.w) * rstd * w1.w);
    }
  }
  __syncthreads();
  {
    const int lane = tid & 63, wv = tid >> 6, fr = lane & 15, fq = lane >> 4;
    const float* W = p.ab_sgu_w + (size_t)g * 128 * 128;
    f32x4 acc[2][8];
#pragma unroll
    for (int i = 0; i < 2; ++i)
#pragma unroll
      for (int j = 0; j < 8; ++j) acc[i][j] = (f32x4){0.f, 0.f, 0.f, 0.f};
#pragma unroll
    for (int s4 = 0; s4 < 4; ++s4) {
      bf16x8 af[2];
#pragma unroll
      for (int i = 0; i < 2; ++i) {
        const float* wp = W + (wv * 32 + i * 16 + fr) * 128 + s4 * 32 + fq * 8;
        const float4 a0 = *(const float4*)wp, a1 = *(const float4*)(wp + 4);
        uint4 pk; pk.x = pack2(a0.x, a0.y); pk.y = pack2(a0.z, a0.w); pk.z = pack2(a1.x, a1.y); pk.w = pack2(a1.z, a1.w);
        af[i] = *(bf16x8*)&pk;
      }
#pragma unroll
      for (int j = 0; j < 8; ++j) {
        const bf16x8 bfr = *(const bf16x8*)(vnT + (j * 16 + fr) * LDV + s4 * 32 + fq * 8);
        acc[0][j] = __builtin_amdgcn_mfma_f32_16x16x32_bf16(bfr, af[0], acc[0][j], 0, 0, 0);
        acc[1][j] = __builtin_amdgcn_mfma_f32_16x16x32_bf16(bfr, af[1], acc[1][j], 0, 0, 0);
      }
    }
#pragma unroll
    for (int i = 0; i < 2; ++i) {
      const int pp = wv * 32 + i * 16 + fr;
      const float bias = p.ab_sgu_b[g * 128 + pp];
#pragma unroll
      for (int j = 0; j < 8; ++j) {
        const int cc = j * 16 + fq * 4;
        const uint2 uu = *(const uint2*)(pb + (size_t)(r0 + pp) * NIN0 + g * 128 + cc);
        uint2 pk;
        pk.x = pack2(lo_bf(uu.x) * (acc[i][j][0] + bias), hi_bf(uu.x) * (acc[i][j][1] + bias));
        pk.y = pack2(lo_bf(uu.y) * (acc[i][j][2] + bias), hi_bf(uu.y) * (acc[i][j][3] + bias));
        *(uint2*)(mix + (size_t)(r0 + pp) * 1024 + g * 128 + cc) = pk;
      }
    }
  }
  __syncthreads();
}

__device__ __forceinline__ void attn_item(const Params& p, bool latent, int b, int rq, int h, const bf16_t* __restrict__ pb, bf16_t* __restrict__ mix, char* smem) {
  int tid = threadIdx.x;
  asm volatile("" : "+v"(tid));
  const int lane = tid & 63, wv = tid >> 6, fr = lane & 15, fq = lane >> 4;
  const int qcol = wv * 16 + fr;
  const int qrow = latent ? (b * 4096 + rq * 64 + qcol) : (ROWS_L + b * 256 + rq * 64 + qcol);
  const int nnb = latent ? 8 : 0, nblk = nnb + 4;
  const int row_start = min(max(rq - 4, 0), 56);
  const int col_start = min(max(qcol - 8, 0), 48);
  const int kc0 = min(max(wv * 16 - 8, 0), 32);
  bf16x8 qf[2];
#pragma unroll
  for (int s2 = 0; s2 < 2; ++s2) {
    const uint4 u = *(const uint4*)(pb + (size_t)qrow * NIN0 + 1024 + h * 64 + s2 * 32 + fq * 8);
    uint4 v;
    v.x = pack2(lo_bf(u.x) * 0.125f, hi_bf(u.x) * 0.125f); v.y = pack2(lo_bf(u.y) * 0.125f, hi_bf(u.y) * 0.125f);
    v.z = pack2(lo_bf(u.z) * 0.125f, hi_bf(u.z) * 0.125f); v.w = pack2(lo_bf(u.w) * 0.125f, hi_bf(u.w) * 0.125f);
    qf[s2] = *(bf16x8*)&v;
  }
  f32x4 o[4];
#pragma unroll
  for (int dt = 0; dt < 4; ++dt) o[dt] = (f32x4){0.f, 0.f, 0.f, 0.f};
  float mrow = -1e30f, lsum = 0.f;
  uint4 rk[2], rv[2];
  auto blk_row = [&](int kb) -> int { return (kb < nnb) ? (b * 4096 + (row_start + kb) * 64) : (ROWS_L + b * 256 + (kb - nnb) * 64); };
  auto gload = [&](int kb) {
    const int r0 = blk_row(kb);
#pragma unroll
    for (int i = 0; i < 2; ++i) {
      const int sidx = tid + i * 256, key = sidx & 63, c8 = sidx >> 6;
      const bf16_t* rp = pb + (size_t)(r0 + key) * NIN0 + h * 64 + c8 * 8;
      rk[i] = *(const uint4*)(rp + 1536);
      rv[i] = *(const uint4*)(rp + 2048);
    }
  };
  auto lstore = [&](int buf) {
    bf16_t* kb_ = (bf16_t*)(smem + buf * 18432);
    bf16_t* vt_ = (bf16_t*)(smem + buf * 18432 + 9216);
#pragma unroll
    for (int i = 0; i < 2; ++i) {
      const int sidx = tid + i * 256, key = sidx & 63, c8 = sidx >> 6;
      *(uint4*)(kb_ + key * LDK + c8 * 8) = rk[i];
      bf16_t* dp = vt_ + (c8 * 8) * LDK + key;
      const uint4 u = rv[i];
      dp[0 * LDK] = (bf16_t)(u.x & 0xffff); dp[1 * LDK] = (bf16_t)(u.x >> 16);
      dp[2 * LDK] = (bf16_t)(u.y & 0xffff); dp[3 * LDK] = (bf16_t)(u.y >> 16);
      dp[4 * LDK] = (bf16_t)(u.z & 0xffff); dp[5 * LDK] = (bf16_t)(u.z >> 16);
      dp[6 * LDK] = (bf16_t)(u.w & 0xffff); dp[7 * LDK] = (bf16_t)(u.w >> 16);
    }
  };
  gload(0);
  lstore(0);
  __syncthreads();
  for (int kb = 0; kb < nblk; ++kb) {
    const int buf = kb & 1;
    if (kb + 1 < nblk) gload(kb + 1);
    const bf16_t* kbuf = (const bf16_t*)(smem + buf * 18432);
    const bf16_t* vtb = (const bf16_t*)(smem + buf * 18432 + 9216);
    const bool nb = kb < nnb;
    const int k0 = nb ? kc0 : 0;
    const int ntile = nb ? 2 : 4;
    f32x4 sc[4];
#pragma unroll
    for (int j = 0; j < 4; ++j) sc[j] = (f32x4){0.f, 0.f, 0.f, 0.f};
#pragma unroll
    for (int j = 0; j < 4; ++j) {
      if (j < ntile) {
#pragma unroll
        for (int s2 = 0; s2 < 2; ++s2) {
          const bf16x8 kf = *(const bf16x8*)(kbuf + (k0 + j * 16 + fr) * LDK + s2 * 32 + fq * 8);
          sc[j] = __builtin_amdgcn_mfma_f32_16x16x32_bf16(kf, qf[s2], sc[j], 0, 0, 0);
        }
      }
    }
    float bm = -1e30f;
    if (nb) {
      const int dr = row_start + kb - rq + 7;
      const float* bp = p.ab_rel_bias + (h * 15 + dr) * 31 + 15 - qcol;
#pragma unroll
      for (int j = 0; j < 2; ++j)
#pragma unroll
        for (int r = 0; r < 4; ++r) {
          const int kc = k0 + j * 16 + fq * 4 + r;
          const bool ok = (kc >= col_start) && (kc < col_start + 16);
          const float v = ok ? sc[j][r] + bp[ok ? kc : qcol] : -1e30f;
          sc[j][r] = v;
          bm = fmaxf(bm, v);
        }
    } else {
#pragma unroll
      for (int j = 0; j < 4; ++j)
#pragma unroll
        for (int r = 0; r < 4; ++r) bm = fmaxf(bm, sc[j][r]);
    }
    bm = fmaxf(bm, __shfl_xor(bm, 16));
    bm = fmaxf(bm, __shfl_xor(bm, 32));
    const float mnew = fmaxf(mrow, bm);
    const float corr = __expf(mrow - mnew);
    mrow = mnew;
    float ps = 0.f;
#pragma unroll
    for (int j = 0; j < 4; ++j)
#pragma unroll
      for (int r = 0; r < 4; ++r) {
        const float pe = (j < ntile) ? __expf(sc[j][r] - mnew) : 0.f;
        sc[j][r] = pe;
        ps += pe;
      }
    lsum = lsum * corr + ps;
#pragma unroll
    for (int dt = 0; dt < 4; ++dt) { o[dt][0] *= corr; o[dt][1] *= corr; o[dt][2] *= corr; o[dt][3] *= corr; }
#pragma unroll
    for (int jp = 0; jp < 2; ++jp) {
      if (jp * 2 < ntile) {
        uint4 pk;
        pk.x = pack2(sc[2 * jp][0], sc[2 * jp][1]); pk.y = pack2(sc[2 * jp][2], sc[2 * jp][3]);
        pk.z = pack2(sc[2 * jp + 1][0], sc[2 * jp + 1][1]); pk.w = pack2(sc[2 * jp + 1][2], sc[2 * jp + 1][3]);
        const bf16x8 pf = *(bf16x8*)&pk;
#pragma unroll
        for (int dt = 0; dt < 4; ++dt) {
          const bf16_t* vp = vtb + (dt * 16 + fr) * LDK + k0 + jp * 32 + fq * 4;
          uint4 vv;
          const uint2 lo = *(const uint2*)vp, hi = *(const uint2*)(vp + 16);
          vv.x = lo.x; vv.y = lo.y; vv.z = hi.x; vv.w = hi.y;
          o[dt] = __builtin_amdgcn_mfma_f32_16x16x32_bf16(*(bf16x8*)&vv, pf, o[dt], 0, 0, 0);
        }
      }
    }
    if (kb + 1 < nblk) lstore(buf ^ 1);
    __syncthreads();
  }
  lsum += __shfl_xor(lsum, 16);
  lsum += __shfl_xor(lsum, 32);
  const float inv = 1.f / lsum;
#pragma unroll
  for (int dt = 0; dt < 4; ++dt) {
    uint2 pk; pk.x = pack2(o[dt][0] * inv, o[dt][1] * inv); pk.y = pack2(o[dt][2] * inv, o[dt][3] * inv);
    *(uint2*)(mix + (size_t)qrow * 1024 + 512 + h * 64 + dt * 16 + fq * 4) = pk;
  }
}

__device__ __forceinline__ void phase_mix0(const Params& p, char* smem) {
  const bf16_t* pb = (const bf16_t*)(p.ws + OFF_BIG);
  bf16_t* mix = (bf16_t*)(p.ws + OFF_HM);
  const int n_sgu = 272 * 4, n_al = 8 * 64 * 8, n_ac = 8 * 4 * 8;
  const int total = n_sgu + n_al + n_ac;
  for (int it = blockIdx.x; it < total; it += gridDim.x) {
    if (it < n_al) { int t = it; attn_item(p, true, t >> 9, (t >> 3) & 63, t & 7, pb, mix, smem); }
    else if (it < n_al + n_ac) { int t = it - n_al; attn_item(p, false, t >> 5, (t >> 3) & 3, t & 7, pb, mix, smem); }
    else { int t = it - n_al - n_ac; sgu_item(p, t >> 2, t & 3, pb, mix, smem); }
  }
}


constexpr size_t OFF_DEC = OFF_BIG + 177 * MiB;
template <int NJ>
__device__ __forceinline__ void wave_mma_lds(const bf16_t* A, const bf16_t* Bt, f32x4 (&acc)[NJ], int fr, int fq) {
#pragma unroll
  for (int s = 0; s < 2; ++s) {
    const bf16x8 a = *(const bf16x8*)(A + fr * LDK + s * 32 + fq * 8);
#pragma unroll
    for (int j = 0; j < NJ; ++j) {
      const bf16x8 b = *(const bf16x8*)(Bt + (j * 16 + fr) * LDK + s * 32 + fq * 8);
      acc[j] = __builtin_amdgcn_mfma_f32_16x16x32_bf16(b, a, acc[j], 0, 0, 0);
    }
  }
}
template <int NJ>
__device__ __forceinline__ void wave_mma_glb(const bf16_t* A, const bf16_t* Btg, f32x4 (&acc)[NJ], int fr, int fq) {
#pragma unroll
  for (int s = 0; s < 2; ++s) {
    const bf16x8 a = *(const bf16x8*)(A + fr * LDK + s * 32 + fq * 8);
#pragma unroll
    for (int j = 0; j < NJ; ++j) {
      const bf16x8 b = *(const bf16x8*)(Btg + (j * 16 + fr) * 64 + s * 32 + fq * 8);
      acc[j] = __builtin_amdgcn_mfma_f32_16x16x32_bf16(b, a, acc[j], 0, 0, 0);
    }
  }
}

template <bool LATENT, bool WANT_OUT, bool WANT_KV>
__device__ __forceinline__ void gla_prep(const Params& p, const bf16_t* __restrict__ pb, int rbase, int h, int dir, int n, char* smem, float* decay_out) {
  bf16_t* kraw = (bf16_t*)smem;
  bf16_t* qraw = (bf16_t*)(smem + 8192);
  float* tot = (float*)(smem + 16384);
  bf16_t* qe = (bf16_t*)(smem + 17408);
  bf16_t* kinv = (bf16_t*)(smem + 26624);
  bf16_t* kdecT = (bf16_t*)(smem + 35840);
  const float* tab = (const float*)(p.ws + OFF_TAB);
  int tid = threadIdx.x;
  asm volatile("" : "+v"(tid));
  const int d = tid & 63, lq = tid >> 6;
#pragma unroll
  for (int i = 0; i < 2; ++i) {
    const int idx = tid + i * 256, l = idx >> 3, c8 = idx & 7;
    const bf16_t* rp = pb + (size_t)(rbase + l) * NIN1P + h * 64 + c8 * 8;
    *(uint4*)(kraw + l * 64 + c8 * 8) = *(const uint4*)(rp + 768);
    if (WANT_OUT) *(uint4*)(qraw + l * 64 + c8 * 8) = *(const uint4*)(rp + 512);
  }
  bf16_t* araw = (bf16_t*)(smem + 63488);
  if (tid < 128) {
    const int l = tid >> 1, hf = tid & 1;
    *(uint4*)(araw + l * 16 + hf * 8) = *(const uint4*)(pb + (size_t)(rbase + l) * NIN1P + 2048 + dir * 16 + hf * 8);
  }
  const float* dw = dir ? p.cd_dw_b : p.cd_dw_f;
  const float* db = dir ? p.cd_db_b : p.cd_db_f;
  float w[16];
#pragma unroll
  for (int j = 0; j < 16; ++j) w[j] = dw[j * 256 + h * 64 + d];
  const float bias = db[h * 64 + d];
  float c[16];
  __syncthreads();
#pragma unroll
  for (int i = 0; i < 16; ++i) {
    const bf16_t* ap = araw + (lq * 16 + i) * 16;
    const uint4 u0 = *(const uint4*)ap, u1 = *(const uint4*)(ap + 8);
    float x = bias;
    x += lo_bf(u0.x) * w[0] + hi_bf(u0.x) * w[1] + lo_bf(u0.y) * w[2] + hi_bf(u0.y) * w[3];
    x += lo_bf(u0.z) * w[4] + hi_bf(u0.z) * w[5] + lo_bf(u0.w) * w[6] + hi_bf(u0.w) * w[7];
    x += lo_bf(u1.x) * w[8] + hi_bf(u1.x) * w[9] + lo_bf(u1.y) * w[10] + hi_bf(u1.y) * w[11];
    x += lo_bf(u1.z) * w[12] + hi_bf(u1.z) * w[13] + lo_bf(u1.w) * w[14] + hi_bf(u1.w) * w[15];
    c[i] = (fminf(x, 0.f) - __logf(1.f + __expf(-fabsf(x)))) * (1.f / 16.f);
    __builtin_amdgcn_sched_barrier(0);
  }
  if (dir == 0) {
#pragma unroll
    for (int i = 1; i < 16; ++i) c[i] += c[i - 1];
    tot[lq * 64 + d] = c[15];
  } else {
#pragma unroll
    for (int i = 14; i >= 0; --i) c[i] += c[i + 1];
    tot[lq * 64 + d] = c[0];
  }
  __syncthreads();
  const float t0 = tot[d], t1 = tot[64 + d], t2 = tot[128 + d], t3 = tot[192 + d];
  const float ctot = (t0 + t1) + (t2 + t3);
  float off;
  if (dir == 0) off = (lq > 0 ? t0 : 0.f) + (lq > 1 ? t1 : 0.f) + (lq > 2 ? t2 : 0.f);
  else off = (lq < 3 ? t3 : 0.f) + (lq < 2 ? t2 : 0.f) + (lq < 1 ? t1 : 0.f);
  float kd_prev = 0.f;
#pragma unroll
  for (int i = 0; i < 16; ++i) {
    const int l = lq * 16 + i;
    const float cc = c[i] + off;
    float kv = bf2f(kraw[l * 64 + d]);
    float qv = WANT_OUT ? bf2f(qraw[l * 64 + d]) : 0.f;
    if (LATENT) {
      const float kp = bf2f(kraw[l * 64 + (d ^ 16)]);
      const int pos = (d < 32) ? n : l;
      const float cs = tab[8576 + pos * 16 + (d & 15)], sn = tab[9600 + pos * 16 + (d & 15)];
      const float sg = (d & 16) ? sn : -sn;
      kv = kv * cs + kp * sg;
      if (WANT_OUT) { const float qp = bf2f(qraw[l * 64 + (d ^ 16)]); qv = qv * cs + qp * sg; }
    }
    if (WANT_OUT) {
      qe[l * LDK + d] = f2bf(qv * 0.125f * __expf(cc));
      kinv[l * LDK + d] = f2bf(kv * __expf(-cc));
    }
    if (WANT_KV) {
      const float kd = kv * __expf(ctot - cc);
      if (i & 1) *(unsigned*)(kdecT + d * LDK + l - 1) = pack2(kd_prev, kd);
      kd_prev = kd;
    }
    __builtin_amdgcn_sched_barrier(0);
  }
  if (WANT_KV && lq == 0) decay_out[d] = __expf(ctot);
}

__device__ __forceinline__ void gla_stage_vT(const bf16_t* __restrict__ pb, int rbase, int h, char* smem) {
  bf16_t* vT = (bf16_t*)(smem + 45056);
  const int tid = threadIdx.x;
#pragma unroll
  for (int i = 0; i < 4; ++i) {
    const int idx = tid + i * 256, l = idx & 63, e8 = idx >> 6;
    const uint4 u = *(const uint4*)(pb + (size_t)(rbase + l) * NIN1P + 1024 + h * 128 + e8 * 8);
    bf16_t* dp = vT + (e8 * 8) * LDK + l;
    dp[0 * LDK] = (bf16_t)(u.x & 0xffff); dp[1 * LDK] = (bf16_t)(u.x >> 16);
    dp[2 * LDK] = (bf16_t)(u.y & 0xffff); dp[3 * LDK] = (bf16_t)(u.y >> 16);
    dp[4 * LDK] = (bf16_t)(u.z & 0xffff); dp[5 * LDK] = (bf16_t)(u.z >> 16);
    dp[6 * LDK] = (bf16_t)(u.w & 0xffff); dp[7 * LDK] = (bf16_t)(u.w >> 16);
  }
}

__device__ __forceinline__ void gla_kv_item(const Params& p, int b, int h, int dir, int j, const bf16_t* __restrict__ pb, char* smem) {
  const int sidx = ((b * 4 + h) * 2 + dir) * 68 + j;
  bf16_t* slot = (bf16_t*)(p.ws + OFF_EXTRA) + (size_t)sidx * 8192;
  float* dec = (float*)(p.ws + OFF_DEC) + (size_t)sidx * 64;
  int rbase;
  if (j < 4) {
    const int nc = dir ? 3 - j : j;
    rbase = ROWS_L + b * 256 + nc * 64;
    gla_prep<false, false, true>(p, pb, rbase, h, dir, 0, smem, dec);
  } else {
    const int jj = j - 4, n = dir ? 63 - jj : jj;
    rbase = b * 4096 + n * 64;
    gla_prep<true, false, true>(p, pb, rbase, h, dir, n, smem, dec);
  }
  gla_stage_vT(pb, rbase, h, smem);
  __syncthreads();
  const bf16_t* kdecT = (const bf16_t*)(smem + 35840);
  const bf16_t* vT = (const bf16_t*)(smem + 45056);
  const int lane = threadIdx.x & 63, wv = threadIdx.x >> 6, fr = lane & 15, fq = lane >> 4;
#pragma unroll
  for (int i2 = 0; i2 < 2; ++i2) {
    f32x4 acc[4];
#pragma unroll
    for (int jn = 0; jn < 4; ++jn) acc[jn] = (f32x4){0.f, 0.f, 0.f, 0.f};
    wave_mma_lds<4>(vT + (wv * 32 + i2 * 16) * LDK, kdecT, acc, fr, fq);
    const int e = wv * 32 + i2 * 16 + fr;
#pragma unroll
    for (int jn = 0; jn < 4; ++jn) {
      uint2 pk; pk.x = pack2(acc[jn][0], acc[jn][1]); pk.y = pack2(acc[jn][2], acc[jn][3]);
      *(uint2*)(slot + e * 64 + jn * 16 + fq * 4) = pk;
    }
  }
  __syncthreads();
}

__device__ __forceinline__ void gla_scan_item(const Params& p, int bhd, int es) {
  const int tid = threadIdx.x, e = es * 16 + (tid >> 4), d0 = (tid & 15) * 4;
  bf16_t* base = (bf16_t*)(p.ws + OFF_EXTRA) + (size_t)bhd * 68 * 8192 + e * 64 + d0;
  const float* dec = (const float*)(p.ws + OFF_DEC) + (size_t)bhd * 68 * 64 + d0;
  float s0 = 0.f, s1 = 0.f, s2 = 0.f, s3 = 0.f;
  for (int jb = 0; jb < 68; jb += 17) {
    uint2 u[17];
    float4 dv[17];
#pragma unroll
    for (int k = 0; k < 17; ++k) {
      u[k] = *(const uint2*)(base + (size_t)(jb + k) * 8192);
      dv[k] = *(const float4*)(dec + (jb + k) * 64);
    }
#pragma unroll
    for (int k = 0; k < 17; ++k) {
      if (jb + k >= 4) {
        uint2 o; o.x = pack2(s0, s1); o.y = pack2(s2, s3);
        *(uint2*)(base + (size_t)(jb + k) * 8192) = o;
      }
      s0 = dv[k].x * s0 + lo_bf(u[k].x); s1 = dv[k].y * s1 + hi_bf(u[k].x);
      s2 = dv[k].z * s2 + lo_bf(u[k].y); s3 = dv[k].w * s3 + hi_bf(u[k].y);
    }
  }
}

__device__ __forceinline__ void gla_out_item(const Params& p, int b, int h, int n, const bf16_t* __restrict__ pb, bf16_t* __restrict__ mix, char* smem) {
  const int rbase = b * 4096 + n * 64;
  const bf16_t* qe = (const bf16_t*)(smem + 17408);
  const bf16_t* kinv = (const bf16_t*)(smem + 26624);
  bf16_t* att = (bf16_t*)(smem + 35840);
  const bf16_t* vT = (const bf16_t*)(smem + 45056);
  int tid_ = threadIdx.x;
  asm volatile("" : "+v"(tid_));
  const int lane = tid_ & 63, wv = tid_ >> 6, fr = lane & 15, fq = lane >> 4;
  f32x4 o[8];
#pragma unroll
  for (int jn = 0; jn < 8; ++jn) o[jn] = (f32x4){0.f, 0.f, 0.f, 0.f};
  gla_stage_vT(pb, rbase, h, smem);
#pragma unroll 1
  for (int dir = 0; dir < 2; ++dir) {
    gla_prep<true, true, false>(p, pb, rbase, h, dir, n, smem, nullptr);
    __syncthreads();
    f32x4 a4[4];
#pragma unroll
    for (int jn = 0; jn < 4; ++jn) a4[jn] = (f32x4){0.f, 0.f, 0.f, 0.f};
    wave_mma_lds<4>(qe + wv * 16 * LDK, kinv, a4, fr, fq);
    const int row = wv * 16 + fr;
#pragma unroll
    for (int jn = 0; jn < 4; ++jn) {
      float v[4];
#pragma unroll
      for (int r = 0; r < 4; ++r) {
        const int col = jn * 16 + fq * 4 + r;
        const bool keep = dir ? (col >= row) : (col <= row);
        v[r] = keep ? a4[jn][r] : 0.f;
      }
      uint2 pk; pk.x = pack2(v[0], v[1]); pk.y = pack2(v[2], v[3]);
      *(uint2*)(att + row * LDK + jn * 16 + fq * 4) = pk;
    }
    __syncthreads();
    wave_mma_lds<8>(att + wv * 16 * LDK, vT, o, fr, fq);
    const int jj = dir ? 63 - n : n;
    const bf16_t* ST = (const bf16_t*)(p.ws + OFF_EXTRA) + (size_t)(((b * 4 + h) * 2 + dir) * 68 + 4 + jj) * 8192;
    wave_mma_glb<8>(qe + wv * 16 * LDK, ST, o, fr, fq);
    __syncthreads();
  }
  float ss = 0.f;
#pragma unroll
  for (int jn = 0; jn < 8; ++jn) ss += o[jn][0] * o[jn][0] + o[jn][1] * o[jn][1] + o[jn][2] * o[jn][2] + o[jn][3] * o[jn][3];
  ss += __shfl_xor(ss, 16);
  ss += __shfl_xor(ss, 32);
  const float rstd = rsqrtf(ss * (1.f / 128.f) + 1e-6f);
  const int trow = rbase + wv * 16 + fr;
#pragma unroll
  for (int jn = 0; jn < 8; ++jn) {
    const int e = jn * 16 + fq * 4;
    const uint2 gq = *(const uint2*)(pb + (size_t)trow * NIN1P + 1536 + h * 128 + e);
    const float4 hw = *(const float4*)(p.cd_head_norm_w + e);
    const float y0 = o[jn][0] * rstd * hw.x * siluf_(lo_bf(gq.x)), y1 = o[jn][1] * rstd * hw.y * siluf_(hi_bf(gq.x));
    const float y2 = o[jn][2] * rstd * hw.z * siluf_(lo_bf(gq.y)), y3 = o[jn][3] * rstd * hw.w * siluf_(hi_bf(gq.y));
    uint2 pk; pk.x = pack2(y0, y1); pk.y = pack2(y2, y3);
    *(uint2*)(mix + (size_t)trow * 1024 + 512 + h * 128 + e) = pk;
  }
}

__device__ __forceinline__ void fft1_item(const Params& p, int b, int g, int t2, const bf16_t* __restrict__ pb, char* smem) {
  bf16_t* GT = (bf16_t*)smem;
  const bf16_t* T1 = (const bf16_t*)(p.ws + OFF_TAB + 65536);
  const bf16_t* C64 = T1 + 32768;
  const bf16_t* S64 = C64 + 4096;
  const bf16_t* NS64 = C64 + 8192;
  const float* tab = (const float*)(p.ws + OFF_TAB);
  int tid = threadIdx.x;
  asm volatile("" : "+v"(tid));
  const int lane = tid & 63, wv = tid >> 6, fr = lane & 15, fq = lane >> 4;
  {
    f32x4 ga[16];
#pragma unroll
    for (int j = 0; j < 16; ++j) ga[j] = (f32x4){0.f, 0.f, 0.f, 0.f};
    const bf16_t* frow = pb + (size_t)(b * 4096 + (wv * 16 + fr) * 64 + t2) * NIN1P + g * 128 + fq * 8;
#pragma unroll
    for (int s4 = 0; s4 < 4; ++s4) {
      const bf16x8 af = *(const bf16x8*)(frow + s4 * 32);
#pragma unroll
      for (int j = 0; j < 16; ++j) {
        const bf16x8 bfr = *(const bf16x8*)(T1 + (j * 16 + fr) * 128 + s4 * 32 + fq * 8);
        ga[j] = __builtin_amdgcn_mfma_f32_16x16x32_bf16(bfr, af, ga[j], 0, 0, 0);
      }
    }
#pragma unroll
    for (int j = 0; j < 16; ++j)
#pragma unroll
      for (int r = 0; r < 4; ++r) GT[(j * 16 + fq * 4 + r) * LDK + wv * 16 + fr] = f2bf(ga[j][r]);
  }
  __syncthreads();
  {
    f32x4 ar[8], ai[8];
#pragma unroll
    for (int j = 0; j < 8; ++j) { ar[j] = (f32x4){0.f, 0.f, 0.f, 0.f}; ai[j] = (f32x4){0.f, 0.f, 0.f, 0.f}; }
    const int k1 = wv * 16 + fr;
#pragma unroll
    for (int s2 = 0; s2 < 2; ++s2) {
      const bf16x8 cf = *(const bf16x8*)(C64 + k1 * 64 + s2 * 32 + fq * 8);
      const bf16x8 sf = *(const bf16x8*)(S64 + k1 * 64 + s2 * 32 + fq * 8);
      const bf16x8 nsf = *(const bf16x8*)(NS64 + k1 * 64 + s2 * 32 + fq * 8);
#pragma unroll
      for (int j = 0; j < 8; ++j) {
        const bf16x8 grf = *(const bf16x8*)(GT + (j * 16 + fr) * LDK + s2 * 32 + fq * 8);
        const bf16x8 gif = *(const bf16x8*)(GT + (128 + j * 16 + fr) * LDK + s2 * 32 + fq * 8);
        ar[j] = __builtin_amdgcn_mfma_f32_16x16x32_bf16(grf, cf, ar[j], 0, 0, 0);
        ar[j] = __builtin_amdgcn_mfma_f32_16x16x32_bf16(gif, sf, ar[j], 0, 0, 0);
        ai[j] = __builtin_amdgcn_mfma_f32_16x16x32_bf16(gif, cf, ai[j], 0, 0, 0);
        ai[j] = __builtin_amdgcn_mfma_f32_16x16x32_bf16(grf, nsf, ai[j], 0, 0, 0);
      }
    }
    const int tw = k1 * t2;
    const float tc = tab[384 + tw], ts = tab[4480 + tw];
    bf16_t* apr = (bf16_t*)p.out + ((size_t)((b * 4 + g) * 64 + k1) * 64 + t2) * 128;
    bf16_t* api = apr + 16777216;
#pragma unroll
    for (int j = 0; j < 8; ++j) {
      uint2 pr, pi;
      pr.x = pack2(ar[j][0] * tc + ai[j][0] * ts, ar[j][1] * tc + ai[j][1] * ts);
      pr.y = pack2(ar[j][2] * tc + ai[j][2] * ts, ar[j][3] * tc + ai[j][3] * ts);
      pi.x = pack2(ai[j][0] * tc - ar[j][0] * ts, ai[j][1] * tc - ar[j][1] * ts);
      pi.y = pack2(ai[j][2] * tc - ar[j][2] * ts, ai[j][3] * tc - ar[j][3] * ts);
      *(uint2*)(apr + j * 16 + fq * 4) = pr;
      *(uint2*)(api + j * 16 + fq * 4) = pi;
    }
  }
  __syncthreads();
}

__device__ __forceinline__ void fft2_item(const Params& p, int b, int g, int k1, bf16_t* __restrict__ mix, char* smem) {
  bf16_t* ArT = (bf16_t*)smem;
  bf16_t* AiT = ArT + 128 * LDK;
  const bf16_t* C64 = (const bf16_t*)(p.ws + OFF_TAB + 65536) + 32768;
  const bf16_t* S64 = C64 + 4096;
  const bf16_t* apr = (const bf16_t*)p.out + (size_t)((b * 4 + g) * 64 + k1) * 64 * 128;
  const bf16_t* api = apr + 16777216;
  int tid = threadIdx.x;
  asm volatile("" : "+v"(tid));
#pragma unroll
  for (int i = 0; i < 4; ++i) {
    const int idx = tid + i * 256, t2 = idx & 63, m8 = idx >> 6;
    const uint4 u = *(const uint4*)(apr + t2 * 128 + m8 * 8);
    const uint4 v = *(const uint4*)(api + t2 * 128 + m8 * 8);
    bf16_t* dr = ArT + (m8 * 8) * LDK + t2;
    bf16_t* di = AiT + (m8 * 8) * LDK + t2;
    dr[0 * LDK] = (bf16_t)(u.x & 0xffff); dr[1 * LDK] = (bf16_t)(u.x >> 16); dr[2 * LDK] = (bf16_t)(u.y & 0xffff); dr[3 * LDK] = (bf16_t)(u.y >> 16);
    dr[4 * LDK] = (bf16_t)(u.z & 0xffff); dr[5 * LDK] = (bf16_t)(u.z >> 16); dr[6 * LDK] = (bf16_t)(u.w & 0xffff); dr[7 * LDK] = (bf16_t)(u.w >> 16);
    di[0 * LDK] = (bf16_t)(v.x & 0xffff); di[1 * LDK] = (bf16_t)(v.x >> 16); di[2 * LDK] = (bf16_t)(v.y & 0xffff); di[3 * LDK] = (bf16_t)(v.y >> 16);
    di[4 * LDK] = (bf16_t)(v.z & 0xffff); di[5 * LDK] = (bf16_t)(v.z >> 16); di[6 * LDK] = (bf16_t)(v.w & 0xffff); di[7 * LDK] = (bf16_t)(v.w >> 16);
  }
  __syncthreads();
  const int lane = tid & 63, wv = tid >> 6, fr = lane & 15, fq = lane >> 4;
  const int k2 = wv * 16 + fr;
  f32x4 x[8];
#pragma unroll
  for (int j = 0; j < 8; ++j) x[j] = (f32x4){0.f, 0.f, 0.f, 0.f};
#pragma unroll
  for (int s2 = 0; s2 < 2; ++s2) {
    const bf16x8 cf = *(const bf16x8*)(C64 + k2 * 64 + s2 * 32 + fq * 8);
    const bf16x8 sf = *(const bf16x8*)(S64 + k2 * 64 + s2 * 32 + fq * 8);
#pragma unroll
    for (int j = 0; j < 8; ++j) {
      const bf16x8 rf = *(const bf16x8*)(ArT + (j * 16 + fr) * LDK + s2 * 32 + fq * 8);
      const bf16x8 jf = *(const bf16x8*)(AiT + (j * 16 + fr) * LDK + s2 * 32 + fq * 8);
      x[j] = __builtin_amdgcn_mfma_f32_16x16x32_bf16(rf, cf, x[j], 0, 0, 0);
      x[j] = __builtin_amdgcn_mfma_f32_16x16x32_bf16(jf, sf, x[j], 0, 0, 0);
    }
  }
  const float scale = 0.0013810679320049757f;
  bf16_t* orow = mix + (size_t)(b * 4096 + k1 + 64 * k2) * 1024 + g * 128;
#pragma unroll
  for (int j = 0; j < 8; ++j) {
    uint2 pk; pk.x = pack2(x[j][0] * scale, x[j][1] * scale); pk.y = pack2(x[j][2] * scale, x[j][3] * scale);
    *(uint2*)(orow + j * 16 + fq * 4) = pk;
  }
  __syncthreads();
}

__device__ __forceinline__ void phase_mix1a(const Params& p, char* smem) {
  const bf16_t* pb = (const bf16_t*)(p.ws + OFF_BIG);
  const int n_kv = 64 * 68, n_f1 = 8 * 4 * 64;
  for (int it = blockIdx.x; it < n_kv + n_f1; it += gridDim.x) {
    if (it < n_kv) { const int bhd = it / 68, j = it % 68; gla_kv_item(p, bhd >> 3, (bhd >> 1) & 3, bhd & 1, j, pb, smem); }
    else { int t = it - n_kv; fft1_item(p, t >> 8, (t >> 6) & 3, t & 63, pb, smem); }
  }
}

__device__ __forceinline__ void phase_mix1b(const Params& p, char* smem) {
  bf16_t* mix = (bf16_t*)(p.ws + OFF_HM);
  const int n_scan = 512, n_f2 = 8 * 4 * 64;
  for (int it = blockIdx.x; it < n_scan + n_f2; it += gridDim.x) {
#ifndef NO_SCAN
    if (it < n_scan) gla_scan_item(p, it >> 3, it & 7); else
#endif
    { int t = it - n_scan; if (t >= 0) fft2_item(p, t >> 8, (t >> 6) & 3, t & 63, mix, smem); }
  }
}

__device__ __forceinline__ void phase_mix1c(const Params& p, char* smem) {
  const bf16_t* pb = (const bf16_t*)(p.ws + OFF_BIG);
  bf16_t* mix = (bf16_t*)(p.ws + OFF_HM);
  for (int it = blockIdx.x; it < 2048; it += gridDim.x) gla_out_item(p, it >> 8, (it >> 6) & 3, it & 63, pb, mix, smem);
}

#ifndef STOP_AFTER
#define STOP_AFTER 107
#define DUMP_OB 1.0f
#define DUMP_AP 0.0f
#endif
__device__ __forceinline__ void dump_bf16(const bf16_t* buf, int ld, int ncols, float* out) {
  for (size_t idx = (size_t)blockIdx.x * NT + threadIdx.x; idx < (size_t)ROWS_L * 1024; idx += (size_t)gridDim.x * NT) {
    const int r = (int)(idx >> 10), c = (int)(idx & 1023);
    float s = 0.f;
    for (int cc = c; cc < ncols; cc += 1024) {
      s += bf2f(buf[(size_t)r * ld + cc]);
      if (r < ROWS_C) s += bf2f(buf[(size_t)(r + ROWS_L) * ld + cc]);
    }
    out[idx] = s;
  }
}
__device__ __forceinline__ void dump_f32(const float* buf, float* out) {
  for (size_t idx = (size_t)blockIdx.x * NT + threadIdx.x; idx < (size_t)ROWS_L * 1024; idx += (size_t)gridDim.x * NT) {
    const int r = (int)(idx >> 10);
    float s = buf[idx];
    if (r < ROWS_C) s += buf[idx + (size_t)ROWS_L * 1024];
    out[idx] = s;
  }
}

#define XB_XCNT(j) (256 + 64 * (j))
#define XB_XSUB(j) (1280 + 64 * (j))
#define XB_XGEN(j) (2304 + 64 * (j))
#define XB_TOP 3328
#define XB_TOPGEN 3392
struct BarState { unsigned x, nloc, nx; };
__device__ __forceinline__ unsigned xb_ld(unsigned* p) { return __hip_atomic_load(p, __ATOMIC_RELAXED, __HIP_MEMORY_SCOPE_AGENT); }
__device__ __forceinline__ unsigned xb_add(unsigned* p, unsigned v) { return __hip_atomic_fetch_add(p, v, __ATOMIC_RELAXED, __HIP_MEMORY_SCOPE_AGENT); }
__device__ __forceinline__ void grid_barrier_post(unsigned* bar, BarState& st) {
  st.x = (unsigned)__builtin_amdgcn_s_getreg((3 << 11) | 20) & 0xFu;
  st.nloc = 0u; st.nx = 0u;
  if (threadIdx.x == 0) (void)xb_add(&bar[XB_XCNT(st.x)], 1u);
}
__device__ __forceinline__ void grid_barrier(unsigned* bar, BarState& st, const float*, float*) {
  asm volatile("s_waitcnt vmcnt(0) lgkmcnt(0)" ::: "memory");
  __syncthreads();
  if (threadIdx.x == 0) {
    if (st.nloc == 0u) {
      const unsigned G = gridDim.x;
      for (;;) {
        unsigned sum = 0u, cnt = 0u, mine = 0u;
#pragma unroll
        for (unsigned j = 0; j < 16; ++j) { const unsigned c = xb_ld(&bar[XB_XCNT(j)]); sum += c; cnt += (c > 0u) ? 1u : 0u; mine = (j == st.x) ? c : mine; }
        if (sum == G) { st.nloc = mine; st.nx = cnt; break; }
        __builtin_amdgcn_s_sleep(1);
      }
    }
    const unsigned old = xb_add(&bar[XB_XSUB(st.x)], 1u);
    const unsigned gen = old / st.nloc;
    if (old + 1u == (gen + 1u) * st.nloc) {
      __builtin_amdgcn_fence(__ATOMIC_RELEASE, "agent");
      asm volatile("s_waitcnt vmcnt(0)" ::: "memory");
      const unsigned og = xb_add(&bar[XB_TOP], 1u);
      const unsigned tg = og / st.nx;
      if (og + 1u == (tg + 1u) * st.nx) (void)xb_add(&bar[XB_TOPGEN], 1u);
      else while (xb_ld(&bar[XB_TOPGEN]) == tg) __builtin_amdgcn_s_sleep(1);
      __builtin_amdgcn_fence(__ATOMIC_ACQUIRE, "agent");
      (void)xb_add(&bar[XB_XGEN(st.x)], 1u);
      asm volatile("s_waitcnt vmcnt(0)" ::: "memory");
    } else {
      while (xb_ld(&bar[XB_XGEN(st.x)]) == gen) __builtin_amdgcn_s_sleep(1);
      __builtin_amdgcn_fence(__ATOMIC_ACQUIRE, "agent");
      asm volatile("s_waitcnt vmcnt(0)" ::: "memory");
    }
  }
  __syncthreads();
}

constexpr int NPHASE = 16;
#ifndef ONLY
#define ONLY -1
#endif
#define PH_EN(n) (ONLY < 0 || ONLY == (n))

template <int PH>
__device__ __forceinline__ void run_phase(const Params& p, char* smem) {
  const float* mod0 = (const float*)(p.ws + OFF_MOD);
  const float* mod1 = mod0 + 9 * MODN;
  float* xres = (float*)(p.ws + OFF_XRES);
  float* xctx = xres + (size_t)ROWS_L * 1024;
  bf16_t* hm = (bf16_t*)(p.ws + OFF_HM);
  bf16_t* big = (bf16_t*)(p.ws + OFF_BIG);
  if (PH == 0) phase_prep(p, smem);
  if (PH == 1) phase_norm(p.x, p.ctx, p.norm_mix_w, mod0, 0, 1024, hm, ROWS);
  if (PH == 2) { Epi e{}; e.C = big; e.ldc = NIN0; e.gelu_cols = 1024;
    gemm_phase<0>(hm, 1024, (const bf16_t*)(p.ws + OFF_WIN0), 1024, ROWS, NIN0, smem, e); }
  if (PH == 3) phase_mix0(p, smem);
  if (PH == 4) { Epi e{}; e.src_lat = p.x; e.src_ctx = p.ctx; e.dst = xres; e.gate = mod0 + 2048;
    gemm_phase<1>(hm, 1024, (const bf16_t*)(p.ws + OFF_WOUT0), 1024, ROWS, 1024, smem, e); }
  if (PH == 5) phase_norm(xres, xctx, p.norm_ffn_w, mod0, 3072, 4096, hm, ROWS);
  if (PH == 6) { Epi e{}; e.C = big; e.ldc = FFN;
    gemm_phase<2>(hm, 1024, (const bf16_t*)(p.ws + OFF_WGU0), 1024, ROWS, 2 * FFN, smem, e); }
  if (PH == 7) { Epi e{}; e.src_lat = xres; e.src_ctx = xctx; e.dst = xres; e.gate = mod0 + 5120;
    gemm_phase<1>(big, FFN, (const bf16_t*)(p.ws + OFF_WD0), FFN, ROWS, 1024, smem, e); }
  if (PH == 8) phase_norm(xres, xctx, p.norm_mix_w + 1024, mod1, 0, 1024, hm, ROWS);
  if (PH == 9) { Epi e{}; e.C = big; e.ldc = NIN1P; e.gelu_cols = 0;
    gemm_phase<0>(hm, 1024, (const bf16_t*)(p.ws + OFF_WIN1), 1024, ROWS, NIN1P, smem, e); }
  if (PH == 10) phase_mix1a(p, smem);
  if (PH == 11) phase_mix1b(p, smem);
  if (PH == 12) phase_mix1c(p, smem);
  if (PH == 13) { Epi e{}; e.src_lat = xres; e.src_ctx = xctx; e.dst = xres; e.gate = mod1 + 2048;
    gemm_phase<1>(hm, 1024, (const bf16_t*)(p.ws + OFF_WOUT1), 1024, ROWS_L, 1024, smem, e); }
  if (PH == 14) phase_norm(xres, xctx, p.norm_ffn_w + 1024, mod1, 3072, 4096, hm, ROWS_L);
  if (PH == 15) { Epi e{}; e.C = big; e.ldc = FFN;
    gemm_phase<2>(hm, 1024, (const bf16_t*)(p.ws + OFF_WGU1), 1024, ROWS_L, 2 * FFN, smem, e); }
  if (PH == 16) { Epi e{}; e.src_lat = xres; e.src_ctx = xctx; e.dst = xres; e.gate = mod1 + 5120;
    gemm_phase<1>(big, FFN, (const bf16_t*)(p.ws + OFF_WD1), FFN, ROWS_L, 1024, smem, e); }
  if (PH == 17) phase_final_norm(xres, p.final_norm_w, p.out);
}
constexpr int NPH = 18;

#ifndef MULTI_LAUNCH
#define MULTI_LAUNCH 0
#endif

#if MULTI_LAUNCH
template <int PH>
__global__ void __launch_bounds__(NT, 2) phase_kernel(Params p) {
  __shared__ __attribute__((aligned(16))) char smem[65536];
  run_phase<PH>(p, smem);
}
template <int PH>
static void launch_phases(const Params& p, int grid, hipStream_t stream) {
  phase_kernel<PH><<<dim3(grid), dim3(NT), 0, stream>>>(p);
  if constexpr (PH + 1 < NPH) launch_phases<PH + 1>(p, grid, stream);
}
#else
template <int PH>
__device__ __forceinline__ void run_all(const Params& p, char* smem, unsigned* bar, BarState& gen) {
  run_phase<PH>(p, smem);
#ifdef DOUBLE_MASK
  if constexpr ((DOUBLE_MASK >> PH) & 1) { grid_barrier(bar, gen, p.x, p.out); run_phase<PH>(p, smem); }
#endif
  if constexpr (PH + 1 < NPH) { grid_barrier(bar, gen, p.x, p.out); run_all<PH + 1>(p, smem, bar, gen); }
}
__global__ void __launch_bounds__(NT, 2) fwd_kernel(Params p) {
  __shared__ __attribute__((aligned(16))) char smem[65536];
  unsigned* bar = (unsigned*)(p.ws + OFF_BAR);
  BarState gen;
  grid_barrier_post(bar, gen);
  run_all<0>(p, smem, bar, gen);
}
#endif

extern "C" void kernel_launch(void* const* d_in, const int* in_sizes, int n_in, void* d_out, int out_size, void* d_ws, size_t ws_size,
                              hipStream_t stream) {
  if (ws_size < WS_NEED) { fprintf(stderr, "workspace too small: %zu\n", ws_size); return; }
  Params p{};
  const float** pp = (const float**)&p;
  for (int i = 0; i < 25; ++i) pp[i] = (const float*)d_in[i];
  p.out = (float*)d_out;
  p.ws = (char*)d_ws;
#if MULTI_LAUNCH
  launch_phases<0>(p, 512, stream);
#else
  static int grid_blocks = 0;
  if (!grid_blocks) {
    int dev = 0, cus = 0, per_cu = 0;
    (void)hipGetDevice(&dev);
    (void)hipDeviceGetAttribute(&cus, hipDeviceAttributeMultiprocessorCount, dev);
    (void)hipOccupancyMaxActiveBlocksPerMultiprocessor(&per_cu, fwd_kernel, NT, 0);
    if (per_cu > 2) per_cu = 2;
    if (per_cu < 1) per_cu = 1;
    grid_blocks = cus * per_cu;
  }
  (void)hipMemsetAsync((char*)d_ws + OFF_BAR, 0, 16384, stream);
  void* args[] = {&p};
  hipError_t err = hipLaunchCooperativeKernel((void*)fwd_kernel, dim3(grid_blocks), dim3(NT), args, 0, stream);
  if (err != hipSuccess) fprintf(stderr, "cooperative launch failed: %s (grid %d)\n", hipGetErrorString(err), grid_blocks);
#endif
}
```
